# Optimizing an MI355X kernel written in HIP

```python
import math
import jax, jax.numpy as jnp
from jax import lax
import numpy as np

D_MODEL = 1024
BATCH = 4
SEQ = 8192
DEPTH = 4

N_BRANCH = 4
BRANCH_W = 256
GM_GROUPS = 4
GM_CHUNK = 128
GM_GD = BRANCH_W // GM_GROUPS
POOL_WINDOWS = (2, 4, 8, 16)
POOL_GD = BRANCH_W // len(POOL_WINDOWS)
ATT_HEADS = 4
ATT_HD = BRANCH_W // ATT_HEADS
IDX_HEADS = 4
IDX_HD = 32
TOPK_MAX = 256
Q_BLOCK = 128
REL_BUCKETS = 32
REL_MAX_DIST = 128
CONV_K = 31
D_FF = 2816
EPS = 1e-6

IN_SIZES = (2 * BRANCH_W, BRANCH_W, BRANCH_W, BRANCH_W, BRANCH_W, IDX_HEADS * IDX_HD, IDX_HD, IDX_HEADS, 2 * BRANCH_W, N_BRANCH * D_MODEL)
IN_COLS = 2 * BRANCH_W + 4 * BRANCH_W + IDX_HEADS * IDX_HD + IDX_HD + IDX_HEADS + 2 * BRANCH_W + N_BRANCH * D_MODEL

kernel_name = 'hybrid_gated_parallel_mixers'


def rmsnorm(x, g):
    xf = x.astype(jnp.float32)
    y = xf * lax.rsqrt(jnp.mean(xf * xf, axis=-1, keepdims=True) + EPS)
    return (y * g.astype(jnp.float32)).astype(x.dtype)


def layernorm(x, g, b):
    xf = x.astype(jnp.float32)
    mu = jnp.mean(xf, axis=-1, keepdims=True)
    xc = xf - mu
    y = xc * lax.rsqrt(jnp.mean(xc * xc, axis=-1, keepdims=True) + EPS)
    return (y * g.astype(jnp.float32) + b.astype(jnp.float32)).astype(x.dtype)


def swiglu_ffn(h, w_gu, w_down):
    a, b = jnp.split(h @ w_gu, 2, axis=-1)
    return (jax.nn.silu(a) * b) @ w_down


def gmlp_mixer(uv, v_g, ws, wb):
    B, S, _ = uv.shape
    u, v = jnp.split(jax.nn.gelu(uv), 2, axis=-1)
    v = rmsnorm(v, v_g)
    vc = v.reshape(B, S // GM_CHUNK, GM_CHUNK, GM_GROUPS, GM_GD)
    causal = jnp.tril(jnp.ones((GM_CHUNK, GM_CHUNK), dtype=bool))
    wsm = jnp.where(causal[None], ws, 0.0).astype(v.dtype)
    mixed = jnp.einsum('gts,bcsgd->bctgd', wsm, vc) + wb.T[None, None, :, :, None]
    return u * mixed.reshape(B, S, BRANCH_W)


def pool_mixer(p, pw, scale):
    B, S, _ = p.shape
    wmax = POOL_WINDOWS[-1]
    pf = p.astype(jnp.float32)
    csp = jnp.pad(jnp.cumsum(pf, axis=1), ((0, 0), (wmax, 0), (0, 0)))
    count = jnp.arange(1, S + 1, dtype=jnp.float32)[:, None]
    outs = []
    for g, w in enumerate(POOL_WINDOWS):
        sl = slice(g * POOL_GD, (g + 1) * POOL_GD)
        win = csp[:, wmax:, sl] - csp[:, wmax - w:wmax - w + S, sl]
        outs.append(win / jnp.minimum(count, float(w)) - pf[:, :, sl])
    d = jnp.stack(outs, axis=2).astype(p.dtype)
    y = jnp.einsum('bsgc,gcd->bsgd', d, pw).reshape(B, S, BRANCH_W)
    return y * scale


def conv_mixer(ab, dw, db, ln_g, ln_b):
    a, gt = jnp.split(ab, 2, axis=-1)
    h = a * jax.nn.sigmoid(gt)
    h = lax.conv_general_dilated(h, dw[:, None, :].astype(h.dtype), window_strides=(1,),
                                 padding=[(CONV_K - 1, 0)], dimension_numbers=('NWC', 'WIO', 'NWC'),
                                 feature_group_count=BRANCH_W) + db
    return jax.nn.silu(layernorm(h, ln_g, ln_b))


def t5_bucket(n):
    n = jnp.maximum(n, 0)
    max_exact = REL_BUCKETS // 2
    large = max_exact + (jnp.log(jnp.maximum(n, 1).astype(jnp.float32) / max_exact)
                         / math.log(REL_MAX_DIST / max_exact) * (REL_BUCKETS - max_exact)).astype(jnp.int32)
    return jnp.where(n < max_exact, n, jnp.minimum(large, REL_BUCKETS - 1))


def sparse_attention(q, k, v, q_idx, k_idx, w_idx, rel_bias):
    B, S, _ = q.shape
    topk = min(TOPK_MAX, S // 4)
    q = q.reshape(B, S, ATT_HEADS, ATT_HD)
    k = k.reshape(B, S, ATT_HEADS, ATT_HD)
    v = v.reshape(B, S, ATT_HEADS, ATT_HD)
    q_idx = q_idx.reshape(B, S, IDX_HEADS, IDX_HD)
    w_idx = w_idx.astype(jnp.float32) * (IDX_HEADS ** -0.5)
    s_pos = jnp.arange(S)
    gather = jax.vmap(lambda a, i: a[i])

    def block(i):
        t0 = i * Q_BLOCK
        t_pos = t0 + jnp.arange(Q_BLOCK)
        qb = lax.dynamic_slice_in_dim(q, t0, Q_BLOCK, axis=1)
        qib = lax.dynamic_slice_in_dim(q_idx, t0, Q_BLOCK, axis=1)
        wib = lax.dynamic_slice_in_dim(w_idx, t0, Q_BLOCK, axis=1)
        rel = jax.nn.relu(jnp.einsum('bqhd,bsd->bqhs', qib, k_idx).astype(jnp.float32) * (IDX_HD ** -0.5))
        score = jnp.einsum('bqh,bqhs->bqs', wib, rel)
        score = jnp.where(s_pos[None, None, :] <= t_pos[None, :, None], score, -jnp.inf)
        _, idx = lax.top_k(score, topk)
        valid = idx <= t_pos[None, :, None]
        ks = gather(k, idx)
        vs = gather(v, idx)
        bias = rel_bias[t5_bucket(t_pos[None, :, None] - idx)]
        logits = (jnp.einsum('bqhd,bqkhd->bqhk', qb, ks).astype(jnp.float32) * (ATT_HD ** -0.5)
                  + bias.astype(jnp.float32).transpose(0, 1, 3, 2))
        logits = jnp.where(valid[:, :, None, :], logits, -jnp.inf)
        p = jax.nn.softmax(logits, axis=-1).astype(v.dtype)
        o = jnp.einsum('bqhk,bqkhd->bqhd', p, vs)
        return o.reshape(B, Q_BLOCK, BRANCH_W)

    out = lax.map(block, jnp.arange(S // Q_BLOCK))
    return out.transpose(1, 0, 2, 3).reshape(B, S, BRANCH_W)


def mixing_sublayer(h, w_in, gm_v_g, gm_ws, gm_b, pool_w, pool_scale, conv_dw, conv_b,
                    conv_ln_g, conv_ln_b, w_branch, w_out, rel_bias):
    B, S, _ = h.shape
    z = h @ w_in
    uv, pz, qz, kz, vz, qi, ki, wi, cz, gz = jnp.split(z, list(np.cumsum(IN_SIZES)[:-1]), axis=-1)
    branches = (
        gmlp_mixer(uv, gm_v_g, gm_ws, gm_b),
        pool_mixer(pz, pool_w, pool_scale),
        sparse_attention(qz, kz, vz, qi, ki, wi, rel_bias),
        conv_mixer(cz, conv_dw, conv_b, conv_ln_g, conv_ln_b),
    )
    gates = jax.nn.sigmoid(gz.reshape(B, S, N_BRANCH, D_MODEL))
    y = gates[:, :, 0] * (branches[0] @ w_branch[0])
    for n in range(1, N_BRANCH):
        y = y + gates[:, :, n] * (branches[n] @ w_branch[n])
    return y @ w_out


def setup_inputs(seed: int = 0) -> dict:
    key = jax.random.key(seed)
    ks = jax.random.split(key, 24)
    f32 = jnp.float32

    def nrm(k, shape, scale):
        return jax.random.normal(k, shape, f32) * scale

    def gain(k, shape):
        return 1.0 + 0.05 * jax.random.normal(k, shape, f32)

    L, D, C, F = DEPTH, D_MODEL, BRANCH_W, D_FF
    return {
        'x': nrm(ks[0], (BATCH, SEQ, D), 1.0),
        'ffn1_pre_g': gain(ks[1], (L, D)),
        'ffn1_post_g': gain(ks[2], (L, D)),
        'ffn1_w_gu': nrm(ks[3], (L, D, 2 * F), D ** -0.5),
        'ffn1_w_down': nrm(ks[4], (L, F, D), F ** -0.5),
        'mix_pre_g': gain(ks[5], (L, D)),
        'mix_post_g': gain(ks[6], (L, D)),
        'w_in': nrm(ks[7], (L, D, IN_COLS), D ** -0.5),
        'gm_v_g': gain(ks[8], (L, C)),
        'gm_ws': nrm(ks[9], (L, GM_GROUPS, GM_CHUNK, GM_CHUNK), GM_CHUNK ** -0.5),
        'gm_b': 1.0 + 0.1 * jax.random.normal(ks[10], (L, GM_GROUPS, GM_CHUNK), f32),
        'pool_w': nrm(ks[11], (L, len(POOL_WINDOWS), POOL_GD, POOL_GD), POOL_GD ** -0.5),
        'pool_scale': gain(ks[12], (L, C)),
        'conv_dw': nrm(ks[13], (L, CONV_K, C), CONV_K ** -0.5),
        'conv_b': nrm(ks[14], (L, C), 0.02),
        'conv_ln_g': gain(ks[15], (L, C)),
        'conv_ln_b': nrm(ks[16], (L, C), 0.02),
        'w_branch': nrm(ks[17], (L, N_BRANCH, C, D), C ** -0.5),
        'w_out': nrm(ks[18], (L, D, D), D ** -0.5),
        'ffn2_pre_g': gain(ks[19], (L, D)),
        'ffn2_post_g': gain(ks[20], (L, D)),
        'ffn2_w_gu': nrm(ks[21], (L, D, 2 * F), D ** -0.5),
        'ffn2_w_down': nrm(ks[22], (L, F, D), F ** -0.5),
        'rel_bias': nrm(ks[23], (REL_BUCKETS, ATT_HEADS), 0.5),
    }


def reference(x, ffn1_pre_g, ffn1_post_g, ffn1_w_gu, ffn1_w_down, mix_pre_g, mix_post_g, w_in,
              gm_v_g, gm_ws, gm_b, pool_w, pool_scale, conv_dw, conv_b, conv_ln_g, conv_ln_b,
              w_branch, w_out, ffn2_pre_g, ffn2_post_g, ffn2_w_gu, ffn2_w_down, rel_bias):
    for l in range(DEPTH):
        h = swiglu_ffn(rmsnorm(x, ffn1_pre_g[l]), ffn1_w_gu[l], ffn1_w_down[l])
        x = x + 0.5 * rmsnorm(h, ffn1_post_g[l])
        h = mixing_sublayer(rmsnorm(x, mix_pre_g[l]), w_in[l], gm_v_g[l], gm_ws[l], gm_b[l],
                            pool_w[l], pool_scale[l], conv_dw[l], conv_b[l], conv_ln_g[l],
                            conv_ln_b[l], w_branch[l], w_out[l], rel_bias)
        x = x + rmsnorm(h, mix_post_g[l])
        h = swiglu_ffn(rmsnorm(x, ffn2_pre_g[l]), ffn2_w_gu[l], ffn2_w_down[l])
        x = x + 0.5 * rmsnorm(h, ffn2_post_g[l])
    return x
```

```cpp
#include <hip/hip_runtime.h>
#include <cstdio>
#include <cstdint>

#define GAS __attribute__((address_space(1)))
#define LAS __attribute__((address_space(3)))
typedef unsigned short bf16;
typedef short bf16x8 __attribute__((ext_vector_type(8)));
typedef float f32x4 __attribute__((ext_vector_type(4)));
typedef float f32x16 __attribute__((ext_vector_type(16)));
typedef unsigned u32x4 __attribute__((ext_vector_type(4)));
typedef unsigned u32x2 __attribute__((ext_vector_type(2)));
typedef GAS unsigned gu32;
#define RLX_AGENT __ATOMIC_RELAXED, __HIP_MEMORY_SCOPE_AGENT

constexpr int NB = 4, SEQ = 8192, DM = 1024, M = NB * SEQ, FF = 2816, DEPTH = 4;
constexpr int ZW = 2048;
constexpr int ZU = 0, ZV = 256, ZP = 512, ZQ = 768, ZK = 1024, ZA = 1280, ZG = 1536;
constexpr float EPS = 1e-6f;
constexpr float LOG2E = 1.4426950408889634f;
constexpr float QSCALE = 0.125f * LOG2E;
constexpr float IDX_SCALE = 0.5f * 0.17677669529663687f;

constexpr size_t MiB = 1u << 20;
constexpr size_t WS_CTL = 0, CTL_ZERO_BYTES = 1 * MiB;
constexpr size_t WS_RSTD = 1 * MiB;
constexpr size_t WS_WSB = 1 * MiB + 256 * 1024;
constexpr size_t WS_PWT = 1 * MiB + 512 * 1024;
constexpr size_t WS_WGU1 = 2 * MiB, WS_WD1 = 13 * MiB, WS_WGU2 = 18 * MiB + 512 * 1024, WS_WD2 = 29 * MiB + 512 * 1024;
constexpr size_t WS_WZ = 35 * MiB, WS_WG = 39 * MiB + 512 * 1024, WS_WB = 47 * MiB + 512 * 1024, WS_WO = 49 * MiB + 512 * 1024;
constexpr size_t WS_XB = 52 * MiB;
constexpr size_t WS_BR = 116 * MiB;
constexpr size_t WS_Y = 180 * MiB;
constexpr size_t WS_AR = 244 * MiB;
constexpr size_t WS_END = 500 * MiB;
constexpr size_t AR_Z = 0, AR_QI = 128 * MiB, AR_KI = 136 * MiB, AR_WI = 138 * MiB, AR_VT = 139 * MiB, AR_M8 = 155 * MiB;
constexpr size_t AR_KC = 188 * MiB;
constexpr size_t AR_HID = 0, AR_HB = 176 * MiB;
constexpr size_t AR_P = 0;
static_assert(WS_WG == WS_WZ + (size_t)2304 * 1024 * 2, "Wz and Wg contiguous");
static_assert(AR_M8 + (size_t)NB * 128 * SEQ * 8 <= 256 * MiB, "arena");

constexpr int CW_TMO = 0;
constexpr int CW_BAR = 4096;

constexpr int LDS_BYTES = 147456;
constexpr int MISC_OFF = 140 * 1024;
constexpr int NWAVES = 8;

#define LDS_WAIT() asm volatile("s_waitcnt lgkmcnt(0)" ::: "memory")
#define VM_WAIT() asm volatile("s_waitcnt vmcnt(0)" ::: "memory")
__device__ __forceinline__ unsigned f2bf(float f) { unsigned u = __builtin_bit_cast(unsigned, f); return (u + 0x7fffu + ((u >> 16) & 1u)) >> 16; }
typedef __bf16 bf16x2_t __attribute__((ext_vector_type(2)));
typedef float f32x2_t __attribute__((ext_vector_type(2)));
__device__ __forceinline__ unsigned pk2(float lo, float hi) { const f32x2_t v = {lo, hi}; const bf16x2_t b = __builtin_convertvector(v, bf16x2_t); return __builtin_bit_cast(unsigned, b); }
__device__ __forceinline__ float bf2f(unsigned short b) { return __builtin_bit_cast(float, (unsigned)b << 16); }
__device__ __forceinline__ float bflo(unsigned w) { return __builtin_bit_cast(float, w << 16); }
__device__ __forceinline__ float bfhi(unsigned w) { return __builtin_bit_cast(float, w & 0xffff0000u); }
__device__ __forceinline__ float fast_exp2(float x) { return __builtin_amdgcn_exp2f(x); }
__device__ __forceinline__ float fast_rcp(float x) { return __builtin_amdgcn_rcpf(x); }
__device__ __forceinline__ float sigmoidf_(float x) { return fast_rcp(1.0f + fast_exp2(-x * LOG2E)); }
__device__ __forceinline__ float siluf_(float x) { return x * sigmoidf_(x); }
__device__ __forceinline__ float gelu_tanh(float x) { const float u = 0.7978845608028654f * (x + 0.044715f * x * x * x); return x * fast_rcp(1.0f + fast_exp2(-2.0f * LOG2E * u)); }
template <int CTRL> __device__ __forceinline__ float dpp_perm(float v) { return __builtin_bit_cast(float, __builtin_amdgcn_update_dpp(0, __builtin_bit_cast(int, v), CTRL, 0xf, 0xf, true)); }
__device__ __forceinline__ float wave_sum(float v) {
    v += dpp_perm<0xB1>(v);
    v += dpp_perm<0x4E>(v);
    v += dpp_perm<0x141>(v);
    v += dpp_perm<0x140>(v);
    const int b = __builtin_bit_cast(int, v);
    const float r0 = __builtin_bit_cast(float, __builtin_amdgcn_readlane(b, 0)), r1 = __builtin_bit_cast(float, __builtin_amdgcn_readlane(b, 16));
    const float r2 = __builtin_bit_cast(float, __builtin_amdgcn_readlane(b, 32)), r3 = __builtin_bit_cast(float, __builtin_amdgcn_readlane(b, 48));
    return (r0 + r1) + (r2 + r3);
}

#define XB_TMO      128
#define XB_XCNT(j)  (256  + 64 * (j))
#define XB_XSUB(j)  (1280 + 64 * (j))
#define XB_XGEN(j)  (2304 + 64 * (j))
#define XB_TOP      3328
#define XB_TOPGEN   3392
#define XCD_BAR_WORDS 3456
#define XB_SPIN_CAP (1u << 22)
__device__ __forceinline__ unsigned xb_ld(unsigned* p)              { return __hip_atomic_load(p, __ATOMIC_RELAXED, __HIP_MEMORY_SCOPE_AGENT); }
__device__ __forceinline__ unsigned xb_add(unsigned* p, unsigned v) { return __hip_atomic_fetch_add(p, v, __ATOMIC_RELAXED, __HIP_MEMORY_SCOPE_AGENT); }
__device__ __forceinline__ unsigned xb_xcc_id() { return (unsigned)__builtin_amdgcn_s_getreg((3 << 11) | 20) & 0xFu; }
#define XB_SPIN(cond, bar) do { unsigned _sp = 0; while (cond) { __builtin_amdgcn_s_sleep(1); \
    if ((++_sp & 255u) == 0u) { if (xb_ld(&(bar)[XB_TMO])) break; if (_sp > XB_SPIN_CAP) { atomicAdd(&(bar)[XB_TMO], 1u); break; } } } } while (0)
struct XcdBarrier { unsigned* bar; unsigned x; volatile LAS unsigned* st; };
__device__ __forceinline__ XcdBarrier xcd_barrier_post(unsigned* bar, volatile LAS unsigned* st) {
    XcdBarrier b; b.bar = bar; b.x = xb_xcc_id(); b.st = st;
    if (threadIdx.x == 0) (void)xb_add(&bar[XB_XCNT(b.x)], 1u);
    return b;
}
__device__ __forceinline__ void xcd_barrier_complete(unsigned* bar, unsigned x, unsigned& nloc, unsigned& nx) {
    const unsigned G = gridDim.x * gridDim.y * gridDim.z;
    unsigned sum, cnt, mine, sp = 0u;
    for (;;) {
        sum = 0u; cnt = 0u; mine = 0u;
#pragma unroll
        for (unsigned j = 0; j < 16; ++j) { const unsigned c = xb_ld(&bar[XB_XCNT(j)]); sum += c; cnt += (c > 0u) ? 1u : 0u; mine = (j == x) ? c : mine; }
        if (sum == G) break;
        __builtin_amdgcn_s_sleep(1);
        if ((++sp & 255u) == 0u) { if (xb_ld(&bar[XB_TMO])) break; if (sp > XB_SPIN_CAP) { atomicAdd(&bar[XB_TMO], 1u); break; } }
    }
    nloc = mine > 0u ? mine : 1u; nx = cnt > 0u ? cnt : 1u;
}
__device__ __forceinline__ void xcd_barrier(const XcdBarrier& b) {
    asm volatile("s_waitcnt vmcnt(0)" ::: "memory");
    __syncthreads();
    if (threadIdx.x == 0) {
        unsigned* bar = b.bar;
        __builtin_amdgcn_s_waitcnt(0);
        unsigned nloc = b.st[0], nx = b.st[1];
        if (nloc == 0u) { xcd_barrier_complete(bar, b.x, nloc, nx); b.st[0] = nloc; b.st[1] = nx; }
        const unsigned old = xb_add(&bar[XB_XSUB(b.x)], 1u);
        const unsigned gen = old / nloc;
        if (old + 1u == (gen + 1u) * nloc) {
            __builtin_amdgcn_fence(__ATOMIC_RELEASE, "agent");
            asm volatile("s_waitcnt vmcnt(0)" ::: "memory");
            const unsigned og = xb_add(&bar[XB_TOP], 1u);
            const unsigned tg = og / nx;
            if (og + 1u == (tg + 1u) * nx) xb_add(&bar[XB_TOPGEN], 1u);
            else XB_SPIN(xb_ld(&bar[XB_TOPGEN]) == tg, bar);
            __builtin_amdgcn_fence(__ATOMIC_ACQUIRE, "agent");
            xb_add(&bar[XB_XGEN(b.x)], 1u);
            asm volatile("s_waitcnt vmcnt(0)" ::: "memory");
        } else {
            XB_SPIN(xb_ld(&bar[XB_XGEN(b.x)]) == gen, bar);
            __builtin_amdgcn_fence(__ATOMIC_ACQUIRE, "agent");
            asm volatile("s_waitcnt vmcnt(0)" ::: "memory");
        }
    }
    __syncthreads();
}

namespace pg8 {
constexpr int BM = 256, BK = 64, HALF = 128, HTB = HALF * BK * 2, STAGE_BYTES = 8 * HTB, NXCD = 8, WGM = 8;
__host__ __device__ __forceinline__ int lds_byte(int r, int c) { const int st = (r >> 4) * 2 + (c >> 5), rr = r & 15, cc = c & 31, ob = rr * 64 + cc * 2; return st * 1024 + (ob ^ (((ob >> 9) & 1) << 5)); }
__host__ __device__ __forceinline__ void stage_rc(int b, int& R, int& C) { const int st = b / 1024, sb = b % 1024, swz = sb ^ (((sb >> 9) & 1) << 5); R = (st >> 1) * 16 + swz / 64; C = (st & 1) * 32 + (swz % 64) / 2; }
__host__ __device__ __forceinline__ int perm32(int rho) { const int n = rho >> 4, i = rho & 15; return 8 * (i >> 2) + 4 * n + (i & 3); }
struct Unit { int pm, pn; };
struct StaticOrder {
    int nM, nN, nwg, G, c;
    __device__ void init(int nM_, int nN_, int G_, int c_) { nM = nM_; nN = nN_; nwg = nM * nN; G = G_; c = c_; }
    __device__ bool next(int i, Unit& u) const {
        const long L = (long)i * G + c; if (L >= nwg) return false;
        int wgid = (int)L; { const int q = nwg / NXCD, r = nwg % NXCD, xcd = wgid % NXCD, off = wgid / NXCD; wgid = (xcd < r ? xcd * (q + 1) : r * (q + 1) + (xcd - r) * q) + off; }
        const int nig = WGM * nN, gid = wgid / nig, fm = gid * WGM, gsz = (nM - fm) < WGM ? (nM - fm) : WGM;
        u.pm = fm + ((wgid % nig) % gsz); u.pn = (wgid % nig) / gsz; return true;
    }
};
typedef int i32x8 __attribute__((ext_vector_type(8)));
typedef int i32x4_ __attribute__((ext_vector_type(4)));
template <class Epi, class Sched, bool ALIGN_EPI, bool SP2, bool FP8 = false>
__device__ __forceinline__ void gemm_phase(LAS unsigned char* lds, const int Kb, const int ldab, const int ldbb, const Sched& S, const Epi& E) {
    int tid_l = threadIdx.x; asm volatile("" : "+v"(tid_l));
    const int tid = tid_l, wid = __builtin_amdgcn_readfirstlane(tid >> 6), lane = tid & 63, wr = wid >> 2, wc = wid & 3, fr = lane & 15, fq = lane >> 4;
    const int nt = Kb / (BK * 2);
    unsigned voffA[2], voffB[2];
#pragma unroll
    for (int i = 0; i < 2; ++i) { int R, C; stage_rc(tid * 16 + i * 8192, R, C); const int Rb = Epi::PERM ? ((R & ~31) + perm32(R & 31)) : R; voffA[i] = (unsigned)(R * ldab + C * 2); voffB[i] = (unsigned)(Rb * ldbb + C * 2); }
    const size_t kstep = (size_t)(BK * 2);
    const size_t hstepA = (size_t)HALF * ldab, hstepB = (size_t)HALF * ldbb;
    const unsigned ldsw = (unsigned)wid * 1024u;
    const int aoff = lds_byte(wr * 64 + fr, fq * 8), boff = lds_byte(wc * 32 + fr, fq * 8);
#define PG8_SA(b, h) (((b) * 2 + (h)) * HTB)
#define PG8_SB(b, h) ((4 + (b) * 2 + (h)) * HTB)
#define PG8_STAGE(bufoff, gbase, voff) do { _Pragma("unroll") for (int _i = 0; _i < 2; ++_i) \
        __builtin_amdgcn_global_load_lds((const unsigned*)((const char*)(gbase) + (voff)[_i]), (LAS unsigned*)(lds + (bufoff) + ldsw + _i * 8192), 16, 0, 0); } while (0)
#define PG8_LDA(dst, b, h) do { _Pragma("unroll") for (int m = 0; m < 4; ++m) _Pragma("unroll") for (int k = 0; k < 2; ++k) dst[m][k] = *(const LAS bf16x8*)(lds + PG8_SA(b, h) + aoff + m * 2048 + k * 1024); } while (0)
#define PG8_LDB(dst, b, h) do { _Pragma("unroll") for (int n = 0; n < 2; ++n) _Pragma("unroll") for (int k = 0; k < 2; ++k) dst[n][k] = *(const LAS bf16x8*)(lds + PG8_SB(b, h) + boff + n * 2048 + k * 1024); } while (0)
#define PG8_CAT(x) __builtin_shufflevector(__builtin_bit_cast(i32x4_, (x)[0]), __builtin_bit_cast(i32x4_, (x)[1]), 0, 1, 2, 3, 4, 5, 6, 7)
#define PG8_MMA(ai, bj, At, Bt) do { __builtin_amdgcn_s_setprio(1); _Pragma("unroll") for (int m = 0; m < 4; ++m) _Pragma("unroll") for (int n = 0; n < 2; ++n) { \
        if constexpr (FP8) asm volatile("v_mfma_f32_16x16x128_f8f6f4 %0, %1, %2, %0" : "+v"(acc[ai][bj][m][n]) : "v"(PG8_CAT(Bt[n])), "v"(PG8_CAT(At[m]))); \
        else { _Pragma("unroll") for (int k = 0; k < 2; ++k) acc[ai][bj][m][n] = __builtin_amdgcn_mfma_f32_16x16x32_bf16(Bt[n][k], At[m][k], acc[ai][bj][m][n], 0, 0, 0); } } __builtin_amdgcn_s_setprio(0); } while (0)
#define PG8_WAIT_V(n) asm volatile("s_waitcnt vmcnt(" #n ")" ::: "memory")
#define PG8_WAIT_L(n) asm volatile("s_waitcnt lgkmcnt(" #n ")" ::: "memory")
#define PG8_BAR __builtin_amdgcn_s_barrier()
#define PG8_SCHED __builtin_amdgcn_sched_barrier(0)
    Unit cur, nxt; int ui = 0;
    if (!S.next(0, cur)) return;
    f32x4 acc[2][2][4][2];
#pragma unroll
    for (int a = 0; a < 2; ++a)
#pragma unroll
        for (int b = 0; b < 2; ++b)
#pragma unroll
            for (int m = 0; m < 4; ++m)
#pragma unroll
                for (int n = 0; n < 2; ++n) acc[a][b][m][n] = (f32x4){0.f, 0.f, 0.f, 0.f};
    bf16x8 At[4][2], B0[2][2], B1[2][2];
    const char* cA = S.a_base(cur); const char* cB = S.b_base(cur);
    if constexpr (SP2) {
        PG8_STAGE(PG8_SB(0, 0), cB, voffB); PG8_STAGE(PG8_SB(0, 1), cB + hstepB, voffB); PG8_STAGE(PG8_SA(0, 0), cA, voffA); PG8_STAGE(PG8_SA(0, 1), cA + hstepA, voffA);
        if (wr == 1) PG8_BAR;
        PG8_WAIT_V(2); PG8_BAR;
        PG8_STAGE(PG8_SB(1, 0), cB + kstep, voffB); PG8_STAGE(PG8_SA(1, 0), cA + kstep, voffA); PG8_STAGE(PG8_SB(1, 1), cB + hstepB + kstep, voffB);
        PG8_WAIT_V(6); PG8_BAR;
    } else {
        PG8_STAGE(PG8_SB(0, 0), cB, voffB); PG8_STAGE(PG8_SA(0, 0), cA, voffA); PG8_STAGE(PG8_SB(0, 1), cB + hstepB, voffB); PG8_STAGE(PG8_SA(0, 1), cA + hstepA, voffA);
        if (wr == 1) PG8_BAR;
        PG8_WAIT_V(4); PG8_BAR;
        PG8_STAGE(PG8_SB(1, 0), cB + kstep, voffB); PG8_STAGE(PG8_SA(1, 0), cA + kstep, voffA); PG8_STAGE(PG8_SB(1, 1), cB + hstepB + kstep, voffB);
        PG8_WAIT_V(6); PG8_BAR;
    }
    for (;;) {
        const bool has_next = S.next(ui + 1, nxt);
        const char* nA = has_next ? S.a_base(nxt) : cA; const char* nB = has_next ? S.b_base(nxt) : cB;
#pragma clang loop unroll(disable)
        for (int t = 0; t < nt; t += 2) {
            const bool last = (t == nt - 2);
            const char* a1 = cA + (size_t)(t + 1) * kstep;
            const char* a2 = last ? nA : cA + (size_t)(t + 2) * kstep; const char* b2 = last ? nB : cB + (size_t)(t + 2) * kstep;
            const char* a3 = a2 + kstep; const char* b3 = b2 + kstep;
            if constexpr (SP2) {
            PG8_LDB(B0, 0, 0); PG8_LDB(B1, 0, 1); PG8_SCHED; PG8_LDA(At, 0, 0); PG8_STAGE(PG8_SA(1, 1), a1 + hstepA, voffA);
            PG8_WAIT_V(8); PG8_WAIT_L(0); PG8_BAR; PG8_MMA(0, 0, At, B0); PG8_MMA(0, 1, At, B1); PG8_BAR; PG8_SCHED;
            PG8_LDA(At, 0, 1); PG8_STAGE(PG8_SB(0, 0), b2, voffB); PG8_STAGE(PG8_SB(0, 1), b2 + hstepB, voffB); PG8_STAGE(PG8_SA(0, 0), a2, voffA);
            PG8_WAIT_V(8); PG8_WAIT_L(0); PG8_BAR; PG8_MMA(1, 0, At, B0); PG8_MMA(1, 1, At, B1); PG8_BAR; PG8_SCHED;
            PG8_LDB(B0, 1, 0); PG8_LDB(B1, 1, 1); PG8_SCHED; PG8_LDA(At, 1, 0); PG8_STAGE(PG8_SA(0, 1), a2 + hstepA, voffA);
            PG8_WAIT_V(8); PG8_WAIT_L(0); PG8_BAR; PG8_MMA(0, 0, At, B0); PG8_MMA(0, 1, At, B1); PG8_BAR; PG8_SCHED;
            PG8_LDA(At, 1, 1); PG8_STAGE(PG8_SB(1, 0), b3, voffB); PG8_STAGE(PG8_SB(1, 1), b3 + hstepB, voffB); PG8_STAGE(PG8_SA(1, 0), a3, voffA);
            PG8_WAIT_V(8); PG8_WAIT_L(0); PG8_BAR; PG8_MMA(1, 0, At, B0); PG8_MMA(1, 1, At, B1); PG8_BAR; PG8_SCHED;
            } else {
            PG8_LDB(B0, 0, 0); PG8_SCHED; PG8_LDA(At, 0, 0); PG8_STAGE(PG8_SA(1, 1), a1 + hstepA, voffA);
            PG8_WAIT_L(8); PG8_BAR; PG8_WAIT_L(0); PG8_MMA(0, 0, At, B0); PG8_BAR; PG8_SCHED;
            PG8_LDB(B1, 0, 1); PG8_STAGE(PG8_SB(0, 0), b2, voffB);
            PG8_BAR; PG8_WAIT_L(0); PG8_MMA(0, 1, At, B1); PG8_BAR;
            PG8_LDA(At, 0, 1); PG8_STAGE(PG8_SA(0, 0), a2, voffA);
            PG8_BAR; PG8_WAIT_L(0); PG8_MMA(1, 0, At, B0); PG8_BAR; PG8_SCHED;
            PG8_STAGE(PG8_SB(0, 1), b2 + hstepB, voffB);
            PG8_WAIT_V(6); PG8_BAR; PG8_MMA(1, 1, At, B1); PG8_BAR;
            PG8_LDB(B0, 1, 0); PG8_SCHED; PG8_LDA(At, 1, 0); PG8_STAGE(PG8_SA(0, 1), a2 + hstepA, voffA);
            PG8_WAIT_L(8); PG8_BAR; PG8_WAIT_L(0); PG8_MMA(0, 0, At, B0); PG8_BAR; PG8_SCHED;
            PG8_LDB(B1, 1, 1); PG8_STAGE(PG8_SB(1, 0), b3, voffB);
            PG8_BAR; PG8_WAIT_L(0); PG8_MMA(0, 1, At, B1); PG8_BAR;
            PG8_LDA(At, 1, 1); PG8_STAGE(PG8_SA(1, 0), a3, voffA);
            PG8_BAR; PG8_WAIT_L(0); PG8_MMA(1, 0, At, B0); PG8_BAR; PG8_SCHED;
            PG8_STAGE(PG8_SB(1, 1), b3 + hstepB, voffB);
            PG8_WAIT_V(6); PG8_BAR; PG8_MMA(1, 1, At, B1); PG8_BAR;
            }
        }
        if constexpr (ALIGN_EPI) { if (wr == 0) PG8_BAR; }
        if constexpr (FP8) {
#pragma unroll
            for (int a = 0; a < 2; ++a)
#pragma unroll
                for (int b = 0; b < 2; ++b)
                    asm volatile("s_nop 15\n\ts_nop 7" : "+v"(acc[a][b][0][0]), "+v"(acc[a][b][0][1]), "+v"(acc[a][b][1][0]), "+v"(acc[a][b][1][1]), "+v"(acc[a][b][2][0]), "+v"(acc[a][b][2][1]), "+v"(acc[a][b][3][0]), "+v"(acc[a][b][3][1])); }
        { Unit eu = cur; int e_fr = fr, e_fq = fq, e_wr = wr, e_wc = wc;
          asm volatile("" : "+s"(eu.pm), "+s"(eu.pn), "+v"(e_fr), "+v"(e_fq), "+s"(e_wr), "+s"(e_wc));
          Epi e2 = E; if constexpr (FP8) e2.launder(); e2(acc, eu, e_wr, e_wc, e_fr, e_fq); }
        if (!has_next) break;
#pragma unroll
        for (int a = 0; a < 2; ++a)
#pragma unroll
            for (int b = 0; b < 2; ++b)
#pragma unroll
                for (int m = 0; m < 4; ++m)
#pragma unroll
                    for (int n = 0; n < 2; ++n) acc[a][b][m][n] = (f32x4){0.f, 0.f, 0.f, 0.f};
        cur = nxt; cA = nA; cB = nB; ++ui;
        if constexpr (ALIGN_EPI) { if (wr == 1) PG8_BAR; }
    }
    PG8_WAIT_V(0);
    if constexpr (!ALIGN_EPI) { if (wr == 0) PG8_BAR; }
    PG8_BAR;
#undef PG8_SA
#undef PG8_SB
#undef PG8_STAGE
#undef PG8_LDA
#undef PG8_LDB
#undef PG8_MMA
#undef PG8_CAT
#undef PG8_WAIT_V
#undef PG8_WAIT_L
#undef PG8_BAR
#undef PG8_SCHED
}
}

struct SchedStd {
    pg8::StaticOrder o; const char* A; const char* B; size_t ta, tb;
    __device__ __forceinline__ bool next(int i, pg8::Unit& u) const { return o.next(i, u); }
    __device__ __forceinline__ const char* a_base(const pg8::Unit& u) const { return A + (size_t)u.pm * ta; }
    __device__ __forceinline__ const char* b_base(const pg8::Unit& u) const { return B + (size_t)u.pn * tb; }
};
struct SchedZ {
    pg8::StaticOrder o; const char* X; const char* W;
    __device__ __forceinline__ bool next(int i, pg8::Unit& u) const { return o.next(i, u); }
    __device__ __forceinline__ const char* a_base(const pg8::Unit& u) const { return u.pn == 8 ? W + (size_t)8 * 256 * 1024 * 2 : X + (size_t)u.pm * 256 * 1024 * 2; }
    __device__ __forceinline__ const char* b_base(const pg8::Unit& u) const { return u.pn == 8 ? X + (size_t)u.pm * 256 * 1024 * 2 : W + (size_t)u.pn * 256 * 1024 * 2; }
};
struct SchedP {
    pg8::StaticOrder o; const char* A; const char* B;
    __device__ __forceinline__ bool next(int i, pg8::Unit& u) const { return o.next(i, u); }
    __device__ __forceinline__ const char* a_base(const pg8::Unit& u) const { return A + (size_t)u.pm * 256 * 1024 * 2 + (size_t)(u.pn >> 2) * 512; }
    __device__ __forceinline__ const char* b_base(const pg8::Unit& u) const { return B + (size_t)u.pn * 256 * 256 * 2; }
};

struct SchedPOwn {
    int wg, G; const char* A; const char* B;
    __device__ __forceinline__ bool next(int i, pg8::Unit& u) const { if (i >= 8 || wg >= 256) return false; u.pm = wg >> 1; u.pn = 4 * (i >> 1) + 2 * (wg & 1) + (i & 1); return true; }
    __device__ __forceinline__ const char* a_base(const pg8::Unit& u) const { return A + (size_t)u.pm * 256 * 1024 * 2 + (size_t)(u.pn >> 2) * 512; }
    __device__ __forceinline__ const char* b_base(const pg8::Unit& u) const { return B + (size_t)u.pn * 256 * 256 * 2; }
};
struct SchedGOwn {
    int wg; const char* A; const char* B;
    __device__ __forceinline__ bool next(int i, pg8::Unit& u) const { if (i >= 8 || wg >= 256) return false; u.pm = wg >> 1; u.pn = 8 * (wg & 1) + i; return true; }
    __device__ __forceinline__ const char* a_base(const pg8::Unit& u) const { return A + (size_t)u.pm * 256 * 1024; }
    __device__ __forceinline__ const char* b_base(const pg8::Unit& u) const { return B + (size_t)u.pn * 256 * 1024; }
};
typedef f32x4 AccT[2][2][4][2];
struct EpiFfn1 {
    static constexpr bool PERM = true;
    bf16* H; const float* rstd;
    __device__ __forceinline__ void launder() { size_t z = 0; asm volatile("" : "+s"(z)); H += z; rstd += z; }
    __device__ __forceinline__ void operator()(const AccT& acc, const pg8::Unit& u, int wr, int wc, int fr, int fq) const {
#pragma unroll
        for (int ai = 0; ai < 2; ++ai)
#pragma unroll
            for (int m = 0; m < 4; ++m) {
                const int row = u.pm * 256 + ai * 128 + wr * 64 + m * 16 + fr; const float rs = 1.0f;
                bf16* hp = H + (size_t)row * FF + u.pn * 128 + wc * 32 + fq * 8;
                const f32x4 g0 = acc[ai][0][m][0] * rs, g1 = acc[ai][0][m][1] * rs, u0 = acc[ai][1][m][0] * rs, u1 = acc[ai][1][m][1] * rs;
                u32x4 w; w.x = pk2(siluf_(g0[0]) * u0[0], siluf_(g0[1]) * u0[1]); w.y = pk2(siluf_(g0[2]) * u0[2], siluf_(g0[3]) * u0[3]);
                w.z = pk2(siluf_(g1[0]) * u1[0], siluf_(g1[1]) * u1[1]); w.w = pk2(siluf_(g1[2]) * u1[2], siluf_(g1[3]) * u1[3]);
                *(u32x4*)hp = w; }
    }
};
struct EpiPlain {
    static constexpr bool PERM = true;
    bf16* O; int ldc;
    __device__ __forceinline__ void launder() { size_t z = 0; asm volatile("" : "+s"(z)); O += z; }
    __device__ __forceinline__ void operator()(const AccT& acc, const pg8::Unit& u, int wr, int wc, int fr, int fq) const {
#pragma unroll
        for (int ai = 0; ai < 2; ++ai)
#pragma unroll
            for (int m = 0; m < 4; ++m) {
                const int row = u.pm * 256 + ai * 128 + wr * 64 + m * 16 + fr;
                bf16* op = O + (size_t)row * ldc + u.pn * 256 + wc * 32 + fq * 8;
#pragma unroll
                for (int bj = 0; bj < 2; ++bj) { const f32x4 v0 = acc[ai][bj][m][0], v1 = acc[ai][bj][m][1];
                    u32x4 w; w.x = pk2(v0[0], v0[1]); w.y = pk2(v0[2], v0[3]); w.z = pk2(v1[0], v1[1]); w.w = pk2(v1[2], v1[3]); *(u32x4*)(op + bj * 128) = w; } }
    }
};
struct EpiZ {
    static constexpr bool PERM = true;
    bf16* Z; bf16* QI; bf16* KI; float* WI; bf16* VT; const float* rstd; bf16* KC;
    __device__ __forceinline__ void launder() { size_t z = 0; asm volatile("" : "+s"(z)); Z += z; QI += z; KI += z; WI += z; VT += z; rstd += z; KC += z; }
    __device__ __forceinline__ void operator()(const AccT& acc, const pg8::Unit& u, int wr, int wc, int fr, int fq) const {
        if (u.pn == 8) {
#pragma unroll
            for (int bj = 0; bj < 2; ++bj) {
                const int tok = u.pm * 256 + bj * 128 + wc * 32 + fq * 8; const float rs0 = 1.0f, rs1 = 1.0f;
#pragma unroll
                for (int ai = 0; ai < 2; ++ai)
#pragma unroll
                    for (int m = 0; m < 4; ++m) { const int c = ai * 128 + wr * 64 + m * 16 + fr; const f32x4 v0 = acc[ai][bj][m][0] * rs0, v1 = acc[ai][bj][m][1] * rs1;
                        const int g0 = tok & ~15, hf = (tok >> 3) & 1;
                        u32x2 wa, wb; wa.x = pk2(v0[0], v0[1]); wa.y = pk2(v0[2], v0[3]); wb.x = pk2(v1[0], v1[1]); wb.y = pk2(v1[2], v1[3]);
                        const int bb = g0 >> 13, tt = g0 & 8191;
                        bf16* vp = VT + ((((size_t)(bb * 4 + (c >> 6)) * 128 + (tt >> 6)) * 64 + (c & 63)) * 64) + (tt & 63);
                        *(u32x2*)(vp + (hf ? 4 : 0)) = wa; *(u32x2*)(vp + (hf ? 12 : 8)) = wb; } }
            return;
        }
        const int pn = u.pn;
#pragma unroll
        for (int ai = 0; ai < 2; ++ai)
#pragma unroll
            for (int m = 0; m < 4; ++m) {
                const int row = u.pm * 256 + ai * 128 + wr * 64 + m * 16 + fr; const float rs = 1.0f;
#pragma unroll
                for (int bj = 0; bj < 2; ++bj) {
                    const int cl = bj * 128 + wc * 32 + fq * 8;
                    f32x4 v0 = acc[ai][bj][m][0] * rs, v1 = acc[ai][bj][m][1] * rs;
                    if (pn < 2) { v0[0] = gelu_tanh(v0[0]); v0[1] = gelu_tanh(v0[1]); v0[2] = gelu_tanh(v0[2]); v0[3] = gelu_tanh(v0[3]); v1[0] = gelu_tanh(v1[0]); v1[1] = gelu_tanh(v1[1]); v1[2] = gelu_tanh(v1[2]); v1[3] = gelu_tanh(v1[3]); }
                    else if (pn == 3) { v0 = v0 * QSCALE; v1 = v1 * QSCALE; }
                    u32x4 w; w.x = pk2(v0[0], v0[1]); w.y = pk2(v0[2], v0[3]); w.z = pk2(v1[0], v1[1]); w.w = pk2(v1[2], v1[3]);
                    if (pn == 7) {
                        if (cl < 128) *(u32x4*)(QI + (size_t)row * 128 + cl) = w;
                        else if (cl < 160) *(u32x4*)(KI + (size_t)row * 32 + (cl - 128)) = w;
                        else if (cl == 160) *(f32x4*)(WI + (size_t)row * 4) = v0;
                    } else if (pn == 4) { const int bb = row >> 13, tt = row & 8191; *(u32x4*)(KC + (((size_t)(bb * 4 + (cl >> 6)) * SEQ + tt) * 64) + (cl & 63)) = w; }
                    else *(u32x4*)(Z + (size_t)row * ZW + pn * 256 + cl) = w;
                } }
    }
};
struct EpiGate {
    static constexpr bool PERM = false;
    const bf16* P; bf16* Y; const float* rstd;
    __device__ __forceinline__ void launder() { size_t z = 0; asm volatile("" : "+s"(z)); P += z; Y += z; rstd += z; }
    __device__ __forceinline__ void operator()(const AccT& acc, const pg8::Unit& u, int wr, int wc, int fr, int fq) const {
#pragma unroll
        for (int ai = 0; ai < 2; ++ai)
#pragma unroll
            for (int m = 0; m < 4; ++m) {
                const int row = u.pm * 256 + ai * 128 + wr * 64 + m * 16 + fr; const float rs = (1.f / 64.f);
                const int j = u.pn * 64 + wc * 16 + fq * 4;
                const bf16* pp = P + (size_t)row * 4096 + j;
                f32x4 y = (f32x4){0.f, 0.f, 0.f, 0.f};
#pragma unroll
                for (int bj = 0; bj < 2; ++bj)
#pragma unroll
                    for (int n = 0; n < 2; ++n) { const u32x2 pw = *(const u32x2*)(pp + (2 * bj + n) * 1024); const f32x4 e = acc[ai][bj][m][n] * (-rs * LOG2E);
                        y[0] += fast_rcp(1.0f + fast_exp2(e[0])) * bflo(pw.x); y[1] += fast_rcp(1.0f + fast_exp2(e[1])) * bfhi(pw.x); y[2] += fast_rcp(1.0f + fast_exp2(e[2])) * bflo(pw.y); y[3] += fast_rcp(1.0f + fast_exp2(e[3])) * bfhi(pw.y); }
                u32x2 w; w.x = pk2(y[0], y[1]); w.y = pk2(y[2], y[3]); *(u32x2*)(Y + (size_t)row * 1024 + j) = w; }
    }
};

struct Frame {
    LAS unsigned char* lds;
    int tid, lane, wave, G, bx;
    unsigned char* ws;
    const float* in[24];
    float* out;
};

template <class RM, int SPLIT8 = 0>
__device__ __forceinline__ void cvt_item(const float* W, int N, const float* gain, bf16* WT, int ldk, LAS float* scr, int kb, int nb, int lane, RM rm, unsigned char* WT8 = nullptr) {
    const int k0 = 64 * kb, n0 = 32 * nb; const int n4 = n0 + (lane & 7) * 4;
    f32x4 v[8]; float g[8];
#pragma unroll
    for (int i = 0; i < 8; ++i) { const int kk = (lane >> 3) + 8 * i; v[i] = (n4 < N) ? *(const f32x4*)(W + (size_t)(k0 + kk) * N + n4) : (f32x4){0.f, 0.f, 0.f, 0.f}; g[i] = gain ? gain[k0 + kk] : 1.f; }
#pragma unroll
    for (int i = 0; i < 8; ++i) { const int kk = (lane >> 3) + 8 * i; LAS float* d = scr + kk * 33 + (lane & 7) * 4; const f32x4 x = v[i] * g[i]; d[0] = x[0]; d[1] = x[1]; d[2] = x[2]; d[3] = x[3]; }
    LDS_WAIT(); asm volatile("" ::: "memory");
    const int c = lane & 7;
#pragma unroll
    for (int j = 0; j < 4; ++j) { const int nl = (lane >> 3) + 8 * j; const int nn = n0 + nl; const int row = (nn < N) ? rm(nn) : -1; const LAS float* s = scr + (8 * c) * 33 + nl;
        u32x4 o; o.x = pk2(s[0 * 33], s[1 * 33]); o.y = pk2(s[2 * 33], s[3 * 33]); o.z = pk2(s[4 * 33], s[5 * 33]); o.w = pk2(s[6 * 33], s[7 * 33]);
        if (SPLIT8 > 0 && row >= SPLIT8) {
            int q0 = 0, q1 = 0; q0 = __builtin_amdgcn_cvt_pk_fp8_f32(s[0 * 33] * 64.f, s[1 * 33] * 64.f, q0, false); q0 = __builtin_amdgcn_cvt_pk_fp8_f32(s[2 * 33] * 64.f, s[3 * 33] * 64.f, q0, true);
            q1 = __builtin_amdgcn_cvt_pk_fp8_f32(s[4 * 33] * 64.f, s[5 * 33] * 64.f, q1, false); q1 = __builtin_amdgcn_cvt_pk_fp8_f32(s[6 * 33] * 64.f, s[7 * 33] * 64.f, q1, true);
            *(u32x2*)(WT8 + (size_t)(row - SPLIT8) * ldk + k0 + 8 * c) = (u32x2){(unsigned)q0, (unsigned)q1};
        } else if (row >= 0) *(u32x4*)(WT + (size_t)row * ldk + k0 + 8 * c) = o; }
    LDS_WAIT(); asm volatile("" ::: "memory");
}
struct RmId { __device__ __forceinline__ int operator()(int n) const { return n; } };
struct RmOff { int off; __device__ __forceinline__ int operator()(int n) const { return n + off; } };
struct RmGu { __device__ __forceinline__ int operator()(int n) const { if (n < FF) return 256 * (n >> 7) + (n & 127); const int j = n - FF; return 256 * (j >> 7) + 128 + (j & 127); } };
struct RmIn { __device__ __forceinline__ int operator()(int n) const {
    if (n < 1280) return n;
    if (n < 1536) return 2048 + (n - 1280);
    if (n < 1700) return 1792 + (n - 1536);
    if (n < 1956) return 1280 + (n - 1700);
    if (n < 2212) return 1536 + (n - 1956);
    const int g = n - 2212, nbr = g >> 10, j = g & 1023, pn = j >> 6, jj = j & 63;
    return 2304 + 256 * pn + 128 * (nbr >> 1) + 32 * (jj >> 4) + 16 * (nbr & 1) + (jj & 15);
} };

__device__ __forceinline__ void convert_layer(Frame& F, int l) {
    LAS float* scr = (LAS float*)(F.lds + F.wave * 16384);
    const int gw = F.bx * NWAVES + F.wave, NGW = F.G * NWAVES, lane = F.lane;
    unsigned char* ws = F.ws;
    constexpr int I_GU = 16 * 176, I_D = 44 * 32, I_IN = 16 * 198, I_B = 4 * 4 * 32, I_O = 16 * 32;
    constexpr int NIT = 2 * I_GU + 2 * I_D + I_IN + I_B + I_O;
    for (int it = gw; it < NIT; it += NGW) {
        int r = it;
        if (r < I_GU) { cvt_item(F.in[3] + (size_t)l * DM * 2 * FF, 2 * FF, F.in[1] + l * DM, (bf16*)(ws + WS_WGU1), DM, scr, r / 176, r % 176, lane, RmGu()); continue; } r -= I_GU;
        if (r < I_GU) { cvt_item(F.in[21] + (size_t)l * DM * 2 * FF, 2 * FF, F.in[19] + l * DM, (bf16*)(ws + WS_WGU2), DM, scr, r / 176, r % 176, lane, RmGu()); continue; } r -= I_GU;
        if (r < I_D) { cvt_item(F.in[4] + (size_t)l * FF * DM, DM, nullptr, (bf16*)(ws + WS_WD1), FF, scr, r / 32, r % 32, lane, RmId()); continue; } r -= I_D;
        if (r < I_D) { cvt_item(F.in[22] + (size_t)l * FF * DM, DM, nullptr, (bf16*)(ws + WS_WD2), FF, scr, r / 32, r % 32, lane, RmId()); continue; } r -= I_D;
        if (r < I_IN) { cvt_item<RmIn, 2304>(F.in[7] + (size_t)l * DM * 6308, 6308, F.in[5] + l * DM, (bf16*)(ws + WS_WZ), DM, scr, r / 198, r % 198, lane, RmIn(), ws + WS_WG); continue; } r -= I_IN;
        if (r < I_B) { const int nbr = r / 128, rr = r % 128; cvt_item(F.in[17] + ((size_t)l * 4 + nbr) * 256 * DM, DM, nullptr, (bf16*)(ws + WS_WB), 256, scr, rr / 32, rr % 32, lane, RmOff{nbr * 1024}); continue; } r -= I_B;
        cvt_item(F.in[18] + (size_t)l * DM * DM, DM, nullptr, (bf16*)(ws + WS_WO), DM, scr, r / 32, r % 32, lane, RmId());
    }
    const int gt = F.bx * 512 + F.tid, NGT = F.G * 512;
    { bf16* wz = (bf16*)(ws + WS_WZ); const int nel = (256 - 164) * 1024 / 8;
      for (int i = gt; i < nel; i += NGT) *(u32x4*)(wz + (size_t)(1792 + 164) * 1024 + (size_t)i * 8) = (u32x4){0u, 0u, 0u, 0u}; }
    { const float* src = F.in[9] + (size_t)l * 4 * 128 * 128; bf16* dst = (bf16*)(ws + WS_WSB);
      for (int i = gt; i < 4 * 128 * 128; i += NGT) { const int t = (i >> 7) & 127, s = i & 127; dst[i] = (bf16)f2bf(s <= t ? src[i] : 0.f); } }
    { const float* src = F.in[11] + (size_t)l * 4 * 64 * 64; bf16* dst = (bf16*)(ws + WS_PWT);
      for (int i = gt; i < 4 * 64 * 64; i += NGT) { const int g = i >> 12, dout = (i >> 6) & 63, cin = i & 63; dst[i] = (bf16)f2bf(src[(g * 64 + cin) * 64 + dout]); } }
}

__device__ __forceinline__ void norm_pass(Frame& F, const bf16* hb, const float* gpost, float alpha, bool init, bool last, bool w8 = false) {
    constexpr int NR = 4;
    const int gw = F.bx * NWAVES + F.wave, NGW = F.G * NWAVES, lane = F.lane;
    bf16* xb = (bf16*)(F.ws + WS_XB); float* rstd = (float*)(F.ws + WS_RSTD);
    f32x4 g[2][2];
#pragma unroll
    for (int j = 0; j < 2; ++j)
#pragma unroll
        for (int k = 0; k < 2; ++k) g[j][k] = init ? (f32x4){0.f, 0.f, 0.f, 0.f} : *(const f32x4*)(gpost + 8 * lane + 512 * j + 4 * k);
    for (int row0 = gw * NR; row0 < M; row0 += NGW * NR) {
        f32x4 x[NR][2][2]; u32x4 hw[NR][2];
        if (init) {
#pragma unroll
            for (int r = 0; r < NR; ++r)
#pragma unroll
                for (int j = 0; j < 2; ++j) { const float* p = F.in[0] + (size_t)(row0 + r) * DM + 8 * lane + 512 * j; x[r][j][0] = *(const f32x4*)p; x[r][j][1] = *(const f32x4*)(p + 4); hw[r][j] = (u32x4){0u, 0u, 0u, 0u}; }
        } else {
            u32x4 xw[NR][2]; float inv[NR];
#pragma unroll
            for (int r = 0; r < NR; ++r) { inv[r] = rstd[row0 + r];
#pragma unroll
                for (int j = 0; j < 2; ++j) { const size_t off = (size_t)(row0 + r) * DM + 8 * lane + 512 * j; xw[r][j] = *(const u32x4*)(xb + off); hw[r][j] = *(const u32x4*)(hb + off); } }
#pragma unroll
            for (int r = 0; r < NR; ++r) { const float iv = 1.0f / inv[r];
#pragma unroll
                for (int j = 0; j < 2; ++j) { x[r][j][0] = (f32x4){bflo(xw[r][j].x), bfhi(xw[r][j].x), bflo(xw[r][j].y), bfhi(xw[r][j].y)} * iv; x[r][j][1] = (f32x4){bflo(xw[r][j].z), bfhi(xw[r][j].z), bflo(xw[r][j].w), bfhi(xw[r][j].w)} * iv; } }
        }
#pragma unroll
        for (int r = 0; r < NR; ++r) {
            const int row = row0 + r;
            if (!init) {
                f32x4 h[2][2]; float ss = 0.f;
#pragma unroll
                for (int j = 0; j < 2; ++j) { h[j][0] = (f32x4){bflo(hw[r][j].x), bfhi(hw[r][j].x), bflo(hw[r][j].y), bfhi(hw[r][j].y)}; h[j][1] = (f32x4){bflo(hw[r][j].z), bfhi(hw[r][j].z), bflo(hw[r][j].w), bfhi(hw[r][j].w)};
#pragma unroll
                    for (int k = 0; k < 2; ++k) ss += (h[j][k][0] * h[j][k][0] + h[j][k][1] * h[j][k][1]) + (h[j][k][2] * h[j][k][2] + h[j][k][3] * h[j][k][3]); }
                const float rr = alpha * __builtin_amdgcn_rsqf(wave_sum(ss) * (1.f / DM) + EPS);
#pragma unroll
                for (int j = 0; j < 2; ++j)
#pragma unroll
                    for (int k = 0; k < 2; ++k) x[r][j][k] = x[r][j][k] + h[j][k] * g[j][k] * rr;
            }
            float s2 = 0.f;
#pragma unroll
            for (int j = 0; j < 2; ++j)
#pragma unroll
                for (int k = 0; k < 2; ++k) { const f32x4 v = x[r][j][k]; s2 += (v[0] * v[0] + v[1] * v[1]) + (v[2] * v[2] + v[3] * v[3]); }
            const float rsn = __builtin_amdgcn_rsqf(wave_sum(s2) * (1.f / DM) + EPS);
#pragma unroll
            for (int j = 0; j < 2; ++j) { const size_t off = (size_t)row * DM + 8 * lane + 512 * j; const f32x4 v0 = x[r][j][0], v1 = x[r][j][1], n0 = v0 * rsn, n1 = v1 * rsn;
                u32x4 w; w.x = pk2(n0[0], n0[1]); w.y = pk2(n0[2], n0[3]); w.z = pk2(n1[0], n1[1]); w.w = pk2(n1[2], n1[3]); *(u32x4*)(xb + off) = w;
                if (last) { *(f32x4*)(F.out + off) = v0; *(f32x4*)(F.out + off + 4) = v1; }
                if (w8) { int q0 = 0, q1 = 0; q0 = __builtin_amdgcn_cvt_pk_fp8_f32(n0[0], n0[1], q0, false); q0 = __builtin_amdgcn_cvt_pk_fp8_f32(n0[2], n0[3], q0, true);
                    q1 = __builtin_amdgcn_cvt_pk_fp8_f32(n1[0], n1[1], q1, false); q1 = __builtin_amdgcn_cvt_pk_fp8_f32(n1[2], n1[3], q1, true); *(u32x2*)((unsigned char*)F.out + off) = (u32x2){(unsigned)q0, (unsigned)q1}; } }
            if (lane == 0) rstd[row] = rsn;
        }
    }
}

__device__ __forceinline__ f32x4 mfma16(bf16x8 a, bf16x8 b, f32x4 c) { return __builtin_amdgcn_mfma_f32_16x16x32_bf16(a, b, c, 0, 0, 0); }
__device__ __forceinline__ void mixers_unit(Frame& F, int l_in, int chunk) {
    const int w = F.wave;
    const int r0 = chunk * 128, b = chunk >> 6, t0 = (chunk & 63) * 128;
    const bf16* Z = (const bf16*)(F.ws + WS_AR + AR_Z); bf16* BR = (bf16*)(F.ws + WS_BR);
    LAS unsigned char* lds = F.lds;
    {
        int l = l_in, tid = F.tid, lane; asm volatile("" : "+s"(l), "+v"(tid)); lane = tid & 63; const int fr = lane & 15, fq = lane >> 4;
        constexpr int VS = 136;
        LAS bf16* vnT = (LAS bf16*)lds;
        const float* vg = F.in[8] + l * 256;
        const f32x4 g4 = *(const f32x4*)(vg + 4 * lane);
        u32x2 wv[16];
#pragma unroll
        for (int i = 0; i < 16; ++i) wv[i] = *(const u32x2*)(Z + (size_t)(r0 + w * 16 + i) * ZW + ZV + 4 * lane);
#pragma unroll
        for (int i = 0; i < 16; ++i) { const int s = w * 16 + i;
            const float v0 = bflo(wv[i].x), v1 = bfhi(wv[i].x), v2 = bflo(wv[i].y), v3 = bfhi(wv[i].y);
            const float rs = __builtin_amdgcn_rsqf(wave_sum((v0 * v0 + v1 * v1) + (v2 * v2 + v3 * v3)) * (1.f / 256) + EPS);
            const unsigned p01 = pk2(v0 * rs * g4[0], v1 * rs * g4[1]), p23 = pk2(v2 * rs * g4[2], v3 * rs * g4[3]);
            vnT[(4 * lane + 0) * VS + s] = (bf16)(p01 & 0xffffu); vnT[(4 * lane + 1) * VS + s] = (bf16)(p01 >> 16);
            vnT[(4 * lane + 2) * VS + s] = (bf16)(p23 & 0xffffu); vnT[(4 * lane + 3) * VS + s] = (bf16)(p23 >> 16); }
        __syncthreads();
        const bf16* wsb = (const bf16*)(F.ws + WS_WSB); const float* gmb = F.in[10] + l * 512;
        const int tt = w, t = 16 * tt + fr;
        const int nkk = (16 * tt + 15) / 32 + 1;
        bf16x8 bfr[4][4]; float wbv[4]; u32x2 uw[4][4];
#pragma unroll
        for (int g = 0; g < 4; ++g) { wbv[g] = gmb[g * 128 + t];
#pragma unroll
            for (int kk = 0; kk < 4; ++kk) bfr[g][kk] = (kk < nkk) ? *(const bf16x8*)(wsb + ((size_t)(g * 128 + t)) * 128 + 32 * kk + 8 * fq) : (bf16x8){0, 0, 0, 0, 0, 0, 0, 0};
#pragma unroll
            for (int ct = 0; ct < 4; ++ct) uw[g][ct] = *(const u32x2*)(Z + (size_t)(r0 + t) * ZW + ZU + 64 * g + 16 * ct + 4 * fq); }
#pragma unroll
        for (int g = 0; g < 4; ++g) {
#pragma unroll
            for (int ct = 0; ct < 4; ++ct) {
                f32x4 acc = (f32x4){0.f, 0.f, 0.f, 0.f};
#pragma unroll
                for (int kk = 0; kk < 4; ++kk) if (kk < nkk) { const bf16x8 a = *(const LAS bf16x8*)(vnT + (64 * g + 16 * ct + fr) * VS + 32 * kk + 8 * fq); acc = mfma16(a, bfr[g][kk], acc); }
                const int c = 64 * g + 16 * ct + 4 * fq; const float wb = wbv[g]; const u32x2 u2 = uw[g][ct];
                u32x2 o; o.x = pk2(bflo(u2.x) * (acc[0] + wb), bfhi(u2.x) * (acc[1] + wb)); o.y = pk2(bflo(u2.y) * (acc[2] + wb), bfhi(u2.y) * (acc[3] + wb));
                *(u32x2*)(BR + (size_t)(r0 + t) * 1024 + c) = o; }
        }
        __syncthreads();
    }
    {
        int l = l_in, tid = F.tid, lane; asm volatile("" : "+s"(l), "+v"(tid)); lane = tid & 63; const int fr = lane & 15, fq = lane >> 4;
        constexpr int DS = 264;
        LAS bf16* pL = (LAS bf16*)lds;
        LAS bf16* dL = (LAS bf16*)(lds + 144 * 512);
        { u32x4 pv[9];
#pragma unroll
          for (int k = 0; k < 9; ++k) { const int it = tid + 512 * k; const int ri = it >> 5, c8 = (it & 31) * 8; const int tp = t0 - 16 + ri;
              pv[k] = (tp >= 0) ? *(const u32x4*)(Z + (size_t)(b * SEQ + tp) * ZW + ZP + c8) : (u32x4){0u, 0u, 0u, 0u}; }
#pragma unroll
          for (int k = 0; k < 9; ++k) { const int it = tid + 512 * k; *(LAS u32x4*)(pL + (size_t)it * 8) = pv[k]; } }
        __syncthreads();
        { const int c = tid & 255, th = tid >> 8, g = c >> 6, wdw = 2 << g;
          const int rs0 = 64 * th + 16; float sum = 0.f;
          for (int i = 1; i < wdw; ++i) sum += bf2f(pL[(rs0 - i) * 256 + c]);
#pragma unroll 8
          for (int i = 0; i < 64; ++i) { const int tp = t0 + 64 * th + i; const float p = bf2f(pL[(rs0 + i) * 256 + c]); sum += p;
              const int cntw = (tp + 1 < wdw) ? tp + 1 : wdw; const float d = sum * fast_rcp((float)cntw) - p;
              dL[(64 * th + i) * DS + c] = (bf16)f2bf(d);
              sum -= bf2f(pL[(rs0 + i - wdw + 1) * 256 + c]); } }
        __syncthreads();
        const bf16* pwT = (const bf16*)(F.ws + WS_PWT); const float* psc = F.in[12] + l * 256;
        const int tt = w, t = 16 * tt + fr;
#pragma unroll
        for (int g = 0; g < 4; ++g) {
            bf16x8 bfr[2];
#pragma unroll
            for (int kk = 0; kk < 2; ++kk) bfr[kk] = *(const LAS bf16x8*)(dL + t * DS + 64 * g + 32 * kk + 8 * fq);
#pragma unroll
            for (int dt = 0; dt < 4; ++dt) {
                f32x4 acc = (f32x4){0.f, 0.f, 0.f, 0.f};
#pragma unroll
                for (int kk = 0; kk < 2; ++kk) { const bf16x8 a = *(const bf16x8*)(pwT + (size_t)(g * 64 + 16 * dt + fr) * 64 + 32 * kk + 8 * fq); acc = mfma16(a, bfr[kk], acc); }
                const int c = 64 * g + 16 * dt + 4 * fq; const f32x4 sc = *(const f32x4*)(psc + c);
                u32x2 o; o.x = pk2(acc[0] * sc[0], acc[1] * sc[1]); o.y = pk2(acc[2] * sc[2], acc[3] * sc[3]);
                *(u32x2*)(BR + (size_t)(r0 + t) * 1024 + 256 + c) = o; }
        }
        __syncthreads();
    }
    {
        int l = l_in, tid = F.tid, lane; asm volatile("" : "+s"(l), "+v"(tid)); lane = tid & 63;
        LAS bf16* hg = (LAS bf16*)lds;
        LAS float* co = (LAS float*)(lds + 94 * 512);
        const int c = tid & 255, tq = tid >> 8;
        float wgt[31];
#pragma unroll
        for (int j = 0; j < 31; ++j) wgt[j] = F.in[13][((size_t)l * 31 + j) * 256 + c];
        const float cb = F.in[14][l * 256 + c];
        const f32x4 lg = *(const f32x4*)(F.in[15] + l * 256 + 4 * lane), lb = *(const f32x4*)(F.in[16] + l * 256 + 4 * lane);
        for (int hh = 0; hh < 2; ++hh) {
            const int tl0 = 64 * hh;
#pragma unroll
            for (int half = 0; half < 2; ++half) {
                u32x2 av[6], gv[6];
#pragma unroll
                for (int k = 0; k < 6; ++k) { const int it = tid + 512 * (6 * half + k); const int ri = it >> 6, c4 = (it & 63) * 4; const int tp = t0 + tl0 - 30 + ri;
                    const bool ok = (it < 94 * 64) && (tp >= 0); const bf16* zr = Z + (size_t)(b * SEQ + (ok ? tp : 0)) * ZW;
                    av[k] = ok ? *(const u32x2*)(zr + ZA + c4) : (u32x2){0u, 0u}; gv[k] = ok ? *(const u32x2*)(zr + ZG + c4) : (u32x2){0u, 0u}; }
#pragma unroll
                for (int k = 0; k < 6; ++k) { const int it = tid + 512 * (6 * half + k); const int ri = it >> 6, c4 = (it & 63) * 4;
                    u32x2 o; o.x = pk2(bflo(av[k].x) * sigmoidf_(bflo(gv[k].x)), bfhi(av[k].x) * sigmoidf_(bfhi(gv[k].x))); o.y = pk2(bflo(av[k].y) * sigmoidf_(bflo(gv[k].y)), bfhi(av[k].y) * sigmoidf_(bfhi(gv[k].y)));
                    if (it < 94 * 64) *(LAS u32x2*)(hg + ri * 256 + c4) = o; }
            }
            __syncthreads();
#pragma unroll 1
            for (int blk = 0; blk < 4; ++blk) {
                const int tb = 32 * tq + 8 * blk; float inp[38];
#pragma unroll
                for (int i = 0; i < 38; ++i) inp[i] = bf2f(hg[(tb + i) * 256 + c]);
#pragma unroll
                for (int o = 0; o < 8; ++o) { float a = cb;
#pragma unroll
                    for (int j = 0; j < 31; ++j) a += wgt[j] * inp[o + j];
                    co[(tb + o) * 256 + c] = a; }
            }
            __syncthreads();
#pragma unroll
            for (int i = 0; i < 8; ++i) { const int tl = w * 8 + i; const f32x4 v = *(const LAS f32x4*)(co + tl * 256 + 4 * lane);
                const float mu = wave_sum((v[0] + v[1]) + (v[2] + v[3])) * (1.f / 256); const f32x4 d = v - mu;
                const float rs = __builtin_amdgcn_rsqf(wave_sum((d[0] * d[0] + d[1] * d[1]) + (d[2] * d[2] + d[3] * d[3])) * (1.f / 256) + EPS);
                const f32x4 y = d * rs * lg + lb;
                u32x2 o; o.x = pk2(siluf_(y[0]), siluf_(y[1])); o.y = pk2(siluf_(y[2]), siluf_(y[3]));
                *(u32x2*)(BR + (size_t)(r0 + tl0 + tl) * 1024 + 768 + 4 * lane) = o; }
            __syncthreads();
        }
    }
}

constexpr int HS = 1028;
constexpr int MSW = 257;
constexpr unsigned R_ALL = 0x7fffffffu;
__device__ __forceinline__ unsigned okey(float s) { const unsigned u = __builtin_bit_cast(unsigned, s); return u ^ ((unsigned)((int)u >> 31) | 0x80000000u); }
template <int CTRL, int RM> __device__ __forceinline__ unsigned dpp_shift(unsigned v) { return (unsigned)__builtin_amdgcn_update_dpp(0, (int)v, CTRL, RM, 0xf, false); }
__device__ __forceinline__ unsigned wave_incl_scan(unsigned v) {
    v += dpp_shift<0x111, 0xf>(v); v += dpp_shift<0x112, 0xf>(v); v += dpp_shift<0x114, 0xf>(v); v += dpp_shift<0x118, 0xf>(v);
    v += dpp_shift<0x142, 0xa>(v);
    v += dpp_shift<0x143, 0xc>(v);
    return v;
}
__device__ __forceinline__ void find_bin4(const LAS unsigned* h0, const unsigned (&Kneed)[4], int lane, unsigned (&bin_out)[4], unsigned (&need_out)[4], unsigned (&cnt_out)[4]) {
    unsigned cnt[4][16]; unsigned s[4], incl[4];
#pragma unroll
    for (int r = 0; r < 4; ++r) { s[r] = 0;
#pragma unroll
        for (int q4 = 0; q4 < 4; ++q4) { const u32x4 v = *(const LAS u32x4*)(h0 + r * HS + 1008 - 16 * lane + 4 * (3 - q4));
            cnt[r][4 * q4 + 0] = v.w; cnt[r][4 * q4 + 1] = v.z; cnt[r][4 * q4 + 2] = v.y; cnt[r][4 * q4 + 3] = v.x; s[r] += (v.x + v.y) + (v.z + v.w); }
        incl[r] = s[r]; }
#pragma unroll
    for (int r = 0; r < 4; ++r) incl[r] = wave_incl_scan(incl[r]);
#pragma unroll
    for (int r = 0; r < 4; ++r) {
        const unsigned excl = incl[r] - s[r];
        unsigned bin = 0, need = 0, cn = 0; const bool mine = (excl < Kneed[r]) && (incl[r] >= Kneed[r]);
        if (mine) { unsigned c = excl; bool done = false;
#pragma unroll
            for (int q = 0; q < 16; ++q) { if (!done) { const unsigned c2 = c + cnt[r][q]; if (c2 >= Kneed[r]) { bin = 1023 - 16 * lane - q; need = Kneed[r] - c; cn = cnt[r][q]; done = true; } c = c2; } } }
        const unsigned long long bal = __ballot(mine); const int src = bal ? (int)__builtin_ctzll(bal) : 0;
        bin_out[r] = (unsigned)__builtin_amdgcn_readlane((int)bin, src); need_out[r] = (unsigned)__builtin_amdgcn_readlane((int)need, src); cnt_out[r] = (unsigned)__builtin_amdgcn_readlane((int)cn, src);
    }
}
typedef float f32x2 __attribute__((ext_vector_type(2)));
__device__ __forceinline__ f32x2 relu_pk(f32x2 d, f32x2 sc) { f32x2 r; asm("v_pk_mul_f32 %0, %1, %2 clamp" : "=v"(r) : "v"(d), "v"(sc)); return r; }
template <int PASS, bool CHECK>
__device__ __forceinline__ void select_tile(const bf16x8 kcur, const bf16x8 (&qf)[2][4], const f32x2 (&av)[2][4], const f32x2 sc2, int kt, int fr, int fq, int t0,
                                            LAS unsigned* hist, const unsigned (&base1)[2], const unsigned (&mytau)[2], const bool (&flagged)[2], bool anyflag) {
    const f32x4 zero4 = (f32x4){0.f, 0.f, 0.f, 0.f};
    const int kbase = 16 * kt + 4 * fq;
    f32x4 dall[2][4];
#pragma unroll
    for (int rg = 0; rg < 2; ++rg)
#pragma unroll
        for (int h = 0; h < 4; ++h) dall[rg][h] = mfma16(kcur, qf[rg][h], zero4);
    asm volatile("s_nop 15" : "+v"(dall[0][0]), "+v"(dall[0][1]), "+v"(dall[0][2]), "+v"(dall[0][3]), "+v"(dall[1][0]), "+v"(dall[1][1]), "+v"(dall[1][2]), "+v"(dall[1][3]));
#pragma unroll
    for (int rg = 0; rg < 2; ++rg) {
        const int rl = 16 * rg + fr, t = t0 + rl;
        f32x2 s01 = (f32x2){96.f, 96.f}, s23 = (f32x2){96.f, 96.f};
#pragma unroll
        for (int h = 0; h < 4; ++h) { const f32x4 d = dall[rg][h];
            const f32x2 r01 = relu_pk((f32x2){d[0], d[1]}, sc2), r23 = relu_pk((f32x2){d[2], d[3]}, sc2);
            s01 = __builtin_elementwise_fma(av[rg][h], r01, s01); s23 = __builtin_elementwise_fma(av[rg][h], r23, s23); }
        const float sv0 = s01[0], sv1 = s01[1], sv2 = s23[0], sv3 = s23[1];
        unsigned bits[4] = {__builtin_bit_cast(unsigned, sv0), __builtin_bit_cast(unsigned, sv1), __builtin_bit_cast(unsigned, sv2), __builtin_bit_cast(unsigned, sv3)};
        if (PASS == 0) {
            const unsigned rowb = (unsigned)(size_t)(hist + rl * HS);
#pragma unroll
            for (int i = 0; i < 4; ++i) { unsigned addr;
                asm("v_bfe_u32 %0, %1, 13, 10\n\tv_lshl_add_u32 %0, %0, 2, %2" : "=&v"(addr) : "v"(bits[i]), "v"(rowb));
                if (!CHECK || kbase + i <= t) __hip_atomic_fetch_add((LAS unsigned*)(size_t)addr, 1u, __ATOMIC_RELAXED, __HIP_MEMORY_SCOPE_WORKGROUP); }
        } else if (PASS == 1) {
#pragma unroll
            for (int i = 0; i < 4; ++i) { const unsigned k20 = __builtin_amdgcn_ubfe(bits[i], 3, 20); unsigned idx = k20 - base1[rg]; idx = idx < 1024u ? idx : 1024u;
                if (CHECK && kbase + i > t) idx = 1024u;
                __hip_atomic_fetch_add(hist + rl * HS + idx, 1u, __ATOMIC_RELAXED, __HIP_MEMORY_SCOPE_WORKGROUP); }
        } else {
            LAS unsigned* sel = hist; LAS unsigned* eqm = hist + 32 * MSW;
            const unsigned taub = 0x42800000u | (mytau[rg] << 3);
            unsigned nib = 0;
#pragma unroll
            for (int i = 3; i >= 0; --i) { const unsigned bb = (!CHECK || kbase + i <= t) ? bits[i] : 0u;
                asm("v_cmp_ge_u32 vcc, %1, %2\n\tv_addc_co_u32 %0, vcc, %0, %0, vcc" : "+v"(nib) : "v"(bb), "v"(taub) : "vcc"); }
            const int sh = 16 * (kt & 1) + 4 * fq;
            __hip_atomic_fetch_or(sel + rl * MSW + (kt >> 1), nib << sh, __ATOMIC_RELAXED, __HIP_MEMORY_SCOPE_WORKGROUP);
            if (anyflag) { unsigned nibe = 0;
#pragma unroll
                for (int i = 0; i < 4; ++i) { const unsigned k20 = __builtin_amdgcn_ubfe(bits[i], 3, 20); const bool v = !CHECK || (kbase + i <= t); if (v && flagged[rg] && k20 == mytau[rg]) nibe |= 1u << i; }
                if (nibe) __hip_atomic_fetch_or(eqm + rl * MSW + (kt >> 1), nibe << sh, __ATOMIC_RELAXED, __HIP_MEMORY_SCOPE_WORKGROUP); }
        }
    }
}
template <int PASS>
__device__ __forceinline__ void select_pass(const bf16* KI, const bf16x8 (&qf)[2][4], const f32x2 (&av)[2][4], int nkt, int j, int w, int fr, int fq, int t0,
                                            LAS unsigned* hist, const unsigned (&base1)[2], const unsigned (&mytau)[2], const bool (&flagged)[2], bool anyflag) {
#define KLOAD(kt) (*(const bf16x8*)((KI + (size_t)(kt) * 512) + kloff))
    const unsigned kloff = (unsigned)(fr * 32 + 8 * fq);
    const f32x2 sc2 = (f32x2){0.0078125f, 0.0078125f};
    const int nfull = 2 * j;
    bf16x8 kq[4];
#pragma unroll
    for (int u = 0; u < 4; ++u) { const int kl = w + 8 * u; kq[u] = KLOAD(kl < nkt ? kl : nkt - 1); }
    for (int kt0 = w; kt0 < nkt; kt0 += 32) {
#pragma unroll
        for (int u = 0; u < 4; ++u) {
            const int kt = kt0 + 8 * u;
            const bf16x8 kcur = kq[u];
            { const int kl = kt + 32; kq[u] = KLOAD(kl < nkt ? kl : nkt - 1); }
            if (kt < nfull) select_tile<PASS, false>(kcur, qf, av, sc2, kt, fr, fq, t0, hist, base1, mytau, flagged, anyflag);
            else select_tile<PASS, true>(kcur, qf, av, sc2, kt, fr, fq, t0, hist, base1, mytau, flagged, anyflag);
        }
    }
#undef KLOAD
}
__device__ __forceinline__ void select_unit(Frame& F, int b, int j) {
    const int tid = F.tid, lane = F.lane, w = F.wave, fr = lane & 15, fq = lane >> 4;
    const int t0 = 32 * j;
    unsigned char* ar = F.ws + WS_AR;
    const bf16* QI = (const bf16*)(ar + AR_QI); const bf16* KI = (const bf16*)(ar + AR_KI) + (size_t)b * SEQ * 32; const float* WI = (const float*)(ar + AR_WI);
    unsigned long long* M8 = (unsigned long long*)(ar + AR_M8);
    LAS unsigned* hist = (LAS unsigned*)F.lds;
    LAS unsigned* info = (LAS unsigned*)(F.lds + 32 * HS * 4);
    bf16x8 qf[2][4]; f32x2 av[2][4];
#pragma unroll
    for (int rg = 0; rg < 2; ++rg) { const size_t grow = (size_t)b * SEQ + t0 + 16 * rg + fr;
#pragma unroll
        for (int h = 0; h < 4; ++h) qf[rg][h] = *(const bf16x8*)(QI + grow * 128 + 32 * h + 8 * fq);
        const f32x4 w4 = *(const f32x4*)(WI + grow * 4); const float sa = __builtin_fabsf(w4[0]) + __builtin_fabsf(w4[1]) + __builtin_fabsf(w4[2]) + __builtin_fabsf(w4[3]);
        const float nrm = sa > 0.f ? 31.0f / sa : 0.f;
#pragma unroll
        for (int h = 0; h < 4; ++h) { const float a = w4[h] * nrm; av[rg][h] = (f32x2){a, a}; } }
    const int nkt = 2 * j + 2;
    LAS unsigned* sel = hist; LAS unsigned* eqm = hist + 32 * MSW;
    { const f32x2 tv = relu_pk((f32x2){(float)lane - 1.5f, 300.f - (float)lane}, (f32x2){0.0078125f, 0.0078125f});
      const float e0 = __builtin_fminf(__builtin_fmaxf(((float)lane - 1.5f) * 0.0078125f, 0.f), 1.f), e1 = __builtin_fminf(__builtin_fmaxf((300.f - (float)lane) * 0.0078125f, 0.f), 1.f);
      if (tv.x != e0 || tv.y != e1) ((float*)(F.ws + WS_RSTD))[0] = __builtin_nanf(""); }
    unsigned base1[2] = {0u, 0u}, mytau[2] = {0u, 0u}; bool flagged[2] = {false, false};
    for (int i = tid; i < 32 * HS; i += 512) hist[i] = 0u;
    __syncthreads();
    select_pass<0>(KI, qf, av, nkt, j, w, fr, fq, t0, hist, base1, mytau, flagged, false);
    __syncthreads();
    { const unsigned kn[4] = {256u, 256u, 256u, 256u}; unsigned bin[4], need[4], cn[4];
      if (t0 + 32 > 256) find_bin4(hist + 4 * w * HS, kn, lane, bin, need, cn);
#pragma unroll
      for (int rr = 0; rr < 4; ++rr) { const int row = 4 * w + rr; const int n = t0 + row + 1;
          if (lane == 0) { if (n <= 256) { info[row] = 0x100000u; info[32 + row] = 0u; } else { info[row] = bin[rr] << 10; info[32 + row] = need[rr]; } } } }
    __syncthreads();
    base1[0] = info[fr]; base1[1] = info[16 + fr];
    __syncthreads();
    for (int i = tid; i < 32 * HS; i += 512) hist[i] = 0u;
    __syncthreads();
    select_pass<1>(KI, qf, av, nkt, j, w, fr, fq, t0, hist, base1, mytau, flagged, false);
    __syncthreads();
    { unsigned kn[4], bin[4], need[4], cn[4];
#pragma unroll
      for (int rr = 0; rr < 4; ++rr) { kn[rr] = info[32 + 4 * w + rr]; if (kn[rr] == 0u) kn[rr] = 1u; }
      if (t0 + 32 > 256) find_bin4(hist + 4 * w * HS, kn, lane, bin, need, cn);
#pragma unroll
      for (int rr = 0; rr < 4; ++rr) { const int row = 4 * w + rr; const int n = t0 + row + 1;
          if (lane == 0) { if (n <= 256) { info[64 + row] = 0u; info[96 + row] = R_ALL; } else { info[64 + row] = info[row] | bin[rr]; info[96 + row] = (need[rr] == cn[rr]) ? R_ALL : need[rr]; } } } }
    __syncthreads();
    mytau[0] = info[64 + fr]; mytau[1] = info[64 + 16 + fr]; flagged[0] = info[96 + fr] != R_ALL; flagged[1] = info[96 + 16 + fr] != R_ALL;
    const bool anyflag = __any(flagged[0] || flagged[1]);
    __syncthreads();
    for (int i = tid; i < 2 * 32 * MSW; i += 512) hist[i] = 0u;
    __syncthreads();
    select_pass<2>(KI, qf, av, nkt, j, w, fr, fq, t0, hist, base1, mytau, flagged, anyflag);
    __syncthreads();
    for (int rr = 0; rr < 4; ++rr) { const int row = 4 * w + rr; const unsigned r = info[96 + row];
        if (r != R_ALL) {
            unsigned ew[4]; unsigned s = 0;
#pragma unroll
            for (int q = 0; q < 4; ++q) { ew[q] = eqm[row * MSW + 4 * lane + q]; s += __builtin_popcount(ew[q]); }
            unsigned incl = s;
            incl = wave_incl_scan(incl);
            unsigned cb = incl - s;
#pragma unroll
            for (int q = 0; q < 4; ++q) { const unsigned ww = ew[q]; const int pc = __builtin_popcount(ww); const int allow = (int)r - (int)cb; unsigned kill;
                if (allow <= 0) kill = ww; else if (allow >= pc) kill = 0u; else { unsigned tmp = ww, kept = 0u; for (int a = 0; a < allow; ++a) { const unsigned low = tmp & (0u - tmp); kept |= low; tmp ^= low; } kill = ww & ~kept; }
                if (kill) sel[row * MSW + 4 * lane + q] &= ~kill; cb += pc; }
        } }
    __syncthreads();
    const int ntw = 4 * (j >> 3) + 4;
    for (int idx = tid; idx < ntw * 32; idx += 512) { const int T = idx >> 5, r2 = idx & 31;
        const unsigned lo = sel[r2 * MSW + 2 * T], hi = sel[r2 * MSW + 2 * T + 1];
        M8[((size_t)(b * 128 + T)) * SEQ + t0 + r2] = (unsigned long long)lo | ((unsigned long long)hi << 32); }
    __syncthreads();
}

__device__ __forceinline__ int crow(int r, int hi) { return (r & 3) + 8 * (r >> 2) + 4 * hi; }
__device__ __forceinline__ f32x16 mfma32(bf16x8 a, bf16x8 b, f32x16 c) { return __builtin_amdgcn_mfma_f32_32x32x16_bf16(a, b, c, 0, 0, 0); }
__device__ __forceinline__ float add_s(float a, float b) { float r; asm("v_add_f32 %0, %1, %2" : "=v"(r) : "v"(a), "v"(b)); return r; }
__device__ __forceinline__ void attn_unit(Frame& F, int b, int h, int qb) {
    constexpr int KST = 144;
    const int tid = F.tid, lane = F.lane, w = F.wave, r32 = lane & 31, hi = lane >> 5;
    unsigned char* ar = F.ws + WS_AR;
    const bf16* Z = (const bf16*)(ar + AR_Z); const bf16* VT = (const bf16*)(ar + AR_VT); const unsigned long long* M8 = (const unsigned long long*)(ar + AR_M8);
    bf16* BR = (bf16*)(F.ws + WS_BR);
    LAS unsigned char* Kb = F.lds; LAS unsigned char* Vb = F.lds + 2 * 64 * KST; LAS float* lut = (LAS float*)(F.lds + 4 * 64 * KST);
    const int q0 = 256 * qb, NT = 4 * qb + 4, q = q0 + 32 * w + r32;
    const size_t grow = (size_t)b * SEQ + q;
    if (tid < 132) { float v = 0.f;
        if (tid < 128) { const int n = tid; int bk = n;
            if (n >= 16) { bk = 16; const int thr[15] = {19, 21, 24, 27, 31, 35, 40, 46, 52, 59, 67, 77, 87, 99, 113};
#pragma unroll
                for (int i = 0; i < 15; ++i) bk += (n >= thr[i]) ? 1 : 0; }
            v = (F.in[23][bk * 4 + h] - F.in[23][31 * 4 + h]) * LOG2E; }
        lut[tid] = v; }
    bf16x8 qf[4];
#pragma unroll
    for (int d0 = 0; d0 < 4; ++d0) qf[d0] = *(const bf16x8*)(Z + grow * ZW + ZQ + 64 * h + 16 * d0 + 8 * hi);
    const int sr = tid >> 3, ch = tid & 7;
    const bf16* kg = (const bf16*)(ar + AR_KC) + ((size_t)(b * 4 + h) * SEQ + sr) * 64 + 8 * ch;
    const bf16* vg = VT + ((size_t)(b * 4 + h) * 128 * 64 + sr) * 64 + 8 * ch;
    const int sdst = sr * KST + 16 * ch;
    const unsigned long long* mp = M8 + (size_t)b * 128 * SEQ + q;
    { const u32x4 k4 = *(const u32x4*)kg, v4 = *(const u32x4*)vg; *(LAS u32x4*)(Kb + sdst) = k4; *(LAS u32x4*)(Vb + sdst) = v4; }
    __syncthreads();
    f32x16 o0 = {}, o1 = {}; f32x16 negm = {}; float mref = 0.f, lsumv = 0.f, lsumw = 0.f;
    unsigned long long mk = mp[0];
    u32x4 kA = *(const u32x4*)(kg + (size_t)1 * 4096), vA = *(const u32x4*)(vg + (size_t)1 * 4096); unsigned long long mA = mp[(size_t)1 * SEQ];
    u32x4 kB = *(const u32x4*)(kg + (size_t)2 * 4096), vB = *(const u32x4*)(vg + (size_t)2 * 4096); unsigned long long mB = mp[(size_t)2 * SEQ];
#define ATT_MATHS(T, buf) do { \
        const LAS unsigned char* Kc = Kb + buf * 64 * KST; const LAS unsigned char* Vc = Vb + buf * 64 * KST; \
        if (64 * T <= q0 + 32 * w + 31) { \
        f32x16 p0 = negm, p1 = negm; \
        { bf16x8 kf[8]; \
        _Pragma("unroll") \
          for (int d0 = 0; d0 < 4; ++d0) { kf[2 * d0] = *(const LAS bf16x8*)(Kc + r32 * KST + 32 * d0 + 16 * hi); kf[2 * d0 + 1] = *(const LAS bf16x8*)(Kc + (32 + r32) * KST + 32 * d0 + 16 * hi); } \
          __builtin_amdgcn_sched_barrier(0); \
        _Pragma("unroll") \
          for (int d0 = 0; d0 < 4; ++d0) { p0 = mfma32(kf[2 * d0], qf[d0], p0); p1 = mfma32(kf[2 * d0 + 1], qf[d0], p1); } \
          __builtin_amdgcn_sched_barrier(0); } \
        if (64 * T + 63 + 128 > q0 + 32 * w) { \
        _Pragma("unroll") \
            for (int r = 0; r < 16; ++r) { const int kv = 64 * T + crow(r, hi); unsigned d = (unsigned)(q - kv); d = d < 128u ? d : 128u; unsigned d2 = (unsigned)(q - kv - 32); d2 = d2 < 128u ? d2 : 128u; \
                p0[r] += lut[d]; p1[r] += lut[d2]; } \
        } \
        float rm = p0[0]; \
        _Pragma("unroll") \
        for (int r = 1; r < 16; ++r) rm = __builtin_fmaxf(rm, p0[r]); \
        _Pragma("unroll") \
        for (int r = 0; r < 16; ++r) rm = __builtin_fmaxf(rm, p1[r]); \
        { const auto rr_ = __builtin_amdgcn_permlane32_swap(__builtin_bit_cast(unsigned, rm), __builtin_bit_cast(unsigned, rm), false, false); rm = __builtin_fmaxf(__builtin_bit_cast(float, rr_[0]), __builtin_bit_cast(float, rr_[1])); } \
        if (T == 0 || __any(rm > 8.f)) { \
            const float dl = (T == 0) ? rm : __builtin_fmaxf(rm, 0.f); mref += dl; \
            const float f = fast_exp2(-dl); lsumv *= f; lsumw *= f; \
        _Pragma("unroll") \
            for (int r = 0; r < 16; ++r) { p0[r] -= dl; p1[r] -= dl; o0[r] *= f; o1[r] *= f; negm[r] = -mref; } \
        } \
        const unsigned mlo = (unsigned)mk >> (4 * hi), mhi = (unsigned)(mk >> 32) >> (4 * hi); \
        _Pragma("unroll") \
        for (int r = 0; r < 16; ++r) { const int pos = (r & 3) + 8 * (r >> 2); \
            unsigned m0 = (unsigned)__builtin_amdgcn_sbfe((int)mlo, pos, 1), m1 = (unsigned)__builtin_amdgcn_sbfe((int)mhi, pos, 1); \
            asm("" : "+v"(m0), "+v"(m1)); \
            p0[r] = __builtin_bit_cast(float, __builtin_bit_cast(unsigned, fast_exp2(p0[r])) & m0); \
            p1[r] = __builtin_bit_cast(float, __builtin_bit_cast(unsigned, fast_exp2(p1[r])) & m1); lsumv = add_s(lsumv, p0[r]); lsumw = add_s(lsumw, p1[r]); } \
        bf16x8 pw[4]; \
        { u32x4 a; a.x = pk2(p0[0], p0[1]); a.y = pk2(p0[2], p0[3]); a.z = pk2(p0[4], p0[5]); a.w = pk2(p0[6], p0[7]); pw[0] = __builtin_bit_cast(bf16x8, a); \
          a.x = pk2(p0[8], p0[9]); a.y = pk2(p0[10], p0[11]); a.z = pk2(p0[12], p0[13]); a.w = pk2(p0[14], p0[15]); pw[1] = __builtin_bit_cast(bf16x8, a); \
          a.x = pk2(p1[0], p1[1]); a.y = pk2(p1[2], p1[3]); a.z = pk2(p1[4], p1[5]); a.w = pk2(p1[6], p1[7]); pw[2] = __builtin_bit_cast(bf16x8, a); \
          a.x = pk2(p1[8], p1[9]); a.y = pk2(p1[10], p1[11]); a.z = pk2(p1[12], p1[13]); a.w = pk2(p1[14], p1[15]); pw[3] = __builtin_bit_cast(bf16x8, a); } \
        { u32x4 vf[8]; \
        _Pragma("unroll") \
          for (int ks = 0; ks < 4; ++ks) { \
              vf[2 * ks] = *(const LAS u32x4*)(Vc + r32 * KST + 32 * ks + 16 * hi); \
              vf[2 * ks + 1] = *(const LAS u32x4*)(Vc + (32 + r32) * KST + 32 * ks + 16 * hi); } \
          __builtin_amdgcn_sched_barrier(0); \
        _Pragma("unroll") \
          for (int ks = 0; ks < 4; ++ks) { o0 = mfma32(__builtin_bit_cast(bf16x8, vf[2 * ks]), pw[ks], o0); o1 = mfma32(__builtin_bit_cast(bf16x8, vf[2 * ks + 1]), pw[ks], o1); } \
          __builtin_amdgcn_sched_barrier(0); } \
        } \
    } while (0)
#define ATT_STEP(T, KS, VS, MS) do { const int T_ = (T); const int buf_ = T_ & 1; ATT_MATHS(T_, buf_); \
        if ((T) + 1 < NT) { *(LAS u32x4*)(Kb + (buf_ ^ 1) * 64 * KST + sdst) = KS; *(LAS u32x4*)(Vb + (buf_ ^ 1) * 64 * KST + sdst) = VS; } \
        mk = MS; \
        { const int tn_ = ((T) + 3 < NT) ? (T) + 3 : NT - 1; KS = *(const u32x4*)(kg + (size_t)tn_ * 4096); VS = *(const u32x4*)(vg + (size_t)tn_ * 4096); MS = mp[(size_t)tn_ * SEQ]; } \
        asm volatile("s_waitcnt lgkmcnt(0)\n\ts_barrier" ::: "memory"); } while (0)
    for (int T = 0; T < NT; T += 2) { ATT_STEP(T, kA, vA, mA); ATT_STEP(T + 1, kB, vB, mB); }
#undef ATT_STEP
#undef ATT_MATHS
    lsumv += lsumw;
    const float lsum = lsumv + __shfl_xor(lsumv, 32);
    const float inv = 1.f / __builtin_fmaxf(lsum, 1e-30f);
    bf16* op = BR + grow * 1024 + 512 + 64 * h + 4 * hi;
#pragma unroll
    for (int g = 0; g < 4; ++g) { u32x2 a; a.x = pk2(o0[4 * g] * inv, o0[4 * g + 1] * inv); a.y = pk2(o0[4 * g + 2] * inv, o0[4 * g + 3] * inv); *(u32x2*)(op + 8 * g) = a;
        u32x2 c; c.x = pk2(o1[4 * g] * inv, o1[4 * g + 1] * inv); c.y = pk2(o1[4 * g + 2] * inv, o1[4 * g + 3] * inv); *(u32x2*)(op + 32 + 8 * g) = c; }
}

struct Args { const float* in[24]; float* out; unsigned char* ws; int ph_lo, ph_hi, layer_lo, layer_hi; };
#define CAS __attribute__((address_space(4)))
struct ArgsDev { const GAS float* in[24]; GAS float* out; GAS unsigned char* ws; int ph_lo, ph_hi, layer_lo, layer_hi; };
constexpr int NPH = 14;
__global__ void __launch_bounds__(512, 2) mega_fwd(Args args) {
    extern __shared__ __attribute__((aligned(16))) unsigned char lds_raw[];
    Frame F;
    F.lds = (LAS unsigned char*)lds_raw;
    F.tid = threadIdx.x; F.lane = F.tid & 63; F.wave = __builtin_amdgcn_readfirstlane(F.tid >> 6);
    F.G = gridDim.x; F.bx = blockIdx.x; F.ws = args.ws; F.out = args.out;
#pragma unroll
    for (int i = 0; i < 24; ++i) F.in[i] = args.in[i];
    volatile LAS unsigned* MISC = (volatile LAS unsigned*)(F.lds + MISC_OFF);
    if (F.tid < 16) MISC[F.tid] = 0u;
    __syncthreads();
    unsigned* ctl = (unsigned*)(F.ws + WS_CTL);
    XcdBarrier bar = xcd_barrier_post(ctl + CW_BAR, MISC + 8);
    const int lo = args.ph_lo, hi = args.ph_hi;
    const bool single = (args.layer_hi - args.layer_lo == 1) && (hi - lo < NPH);
#ifndef PHMASK
#define PHMASK 0x3fff
#endif
#ifndef DUPMASK
#define DUPMASK 0
#endif
#define REP(k) for (int rep_ = 0; rep_ < (((DUPMASK) >> (k)) & 1) + 1; ++rep_)
#define IN(k) (((PHMASK >> (k)) & 1) && lo <= (k) && (k) < hi)
#define SEAM(k) do { if (!single || (IN(k) && IN((k) + 1))) xcd_barrier(bar); } while (0)
#define PHASE_ENTER() unsigned char* ws; { size_t z_ = 0; int t_ = threadIdx.x; int b_ = blockIdx.x; asm volatile("" : "+s"(z_), "+v"(t_), "+s"(b_)); \
    const CAS ArgsDev* ap = (const CAS ArgsDev*)((const CAS char*)__builtin_amdgcn_kernarg_segment_ptr() + z_); \
    _Pragma("unroll") for (int i_ = 0; i_ < 24; ++i_) F.in[i_] = (const float*)ap->in[i_]; F.out = (float*)ap->out; ws = (unsigned char*)ap->ws; F.ws = ws; F.tid = t_; F.lane = t_ & 63; F.wave = __builtin_amdgcn_readfirstlane(t_ >> 6); F.bx = b_; } \
    unsigned char* ar = ws + WS_AR; const float* rstd = (const float*)(ws + WS_RSTD); const char* xb = (const char*)(ws + WS_XB); (void)ar; (void)rstd; (void)xb;
    for (int l = args.layer_lo; l < args.layer_hi; ++l) {
        if (IN(0) && l == args.layer_lo) { PHASE_ENTER(); REP(0) convert_layer(F, l); if (l == 0) norm_pass(F, nullptr, nullptr, 0.f, true, false); SEAM(0); }
        if (IN(1)) { PHASE_ENTER(); SchedStd S; S.o.init(128, 22, F.G, F.bx); S.A = xb; S.B = (const char*)(ws + WS_WGU1); S.ta = (size_t)256 * 1024 * 2; S.tb = (size_t)256 * 1024 * 2;
            EpiFfn1 E{(bf16*)(ar + AR_HID), rstd}; REP(1) pg8::gemm_phase<EpiFfn1, SchedStd, true, true>(F.lds, 2048, 2048, 2048, S, E); SEAM(1); }
        if (IN(2)) { PHASE_ENTER(); SchedStd S; S.o.init(128, 4, F.G, F.bx); S.A = (const char*)(ar + AR_HID); S.B = (const char*)(ws + WS_WD1); S.ta = (size_t)256 * FF * 2; S.tb = (size_t)256 * FF * 2;
            EpiPlain E{(bf16*)(ar + AR_HB), 1024}; REP(2) pg8::gemm_phase<EpiPlain, SchedStd, true, true>(F.lds, FF * 2, FF * 2, FF * 2, S, E); SEAM(2); }
        if (IN(3)) { PHASE_ENTER(); norm_pass(F, (const bf16*)(ar + AR_HB), F.in[2] + l * DM, 0.5f, false, false, true); SEAM(3); }
        if (IN(4)) { PHASE_ENTER(); SchedZ S; S.o.init(128, 9, F.G, F.bx); S.X = xb; S.W = (const char*)(ws + WS_WZ);
            EpiZ E{(bf16*)(ar + AR_Z), (bf16*)(ar + AR_QI), (bf16*)(ar + AR_KI), (float*)(ar + AR_WI), (bf16*)(ar + AR_VT), rstd, (bf16*)(ar + AR_KC)};
            REP(4) pg8::gemm_phase<EpiZ, SchedZ, true, true>(F.lds, 2048, 2048, 2048, S, E); SEAM(4); }
        if (IN(5)) { PHASE_ENTER();
#ifndef NO_MIX
            REP(14) for (int c = F.bx; c < 256; c += F.G) mixers_unit(F, l, c);
#endif
#ifndef NO_SEL
            REP(15) for (int i = 0; i < 4; ++i) { const int wgi = F.bx; if (wgi >= 256) break; const int u = (i == 0) ? wgi : (i == 1) ? 511 - wgi : (i == 2) ? 512 + wgi : 1023 - wgi; select_unit(F, u & 3, u >> 2); }
#endif
            SEAM(5); }
        if (IN(6)) { PHASE_ENTER(); REP(6) for (int i = 0; i < 2; ++i) { const int wgi = F.bx; if (wgi >= 256) break; const int bh = 2 * (wgi & 7) + (wgi >> 7), s = (wgi >> 3) & 15;     attn_unit(F, bh >> 2, bh & 3, i == 0 ? 31 - s : s); __syncthreads(); } SEAM(6); }
        if (IN(7)) { PHASE_ENTER();
            { SchedPOwn S; S.wg = F.bx; S.G = F.G; S.A = (const char*)(ws + WS_BR); S.B = (const char*)(ws + WS_WB);
              EpiPlain E{(bf16*)(ar + AR_P), 4096}; pg8::gemm_phase<EpiPlain, SchedPOwn, true, true>(F.lds, 512, 2048, 512, S, E); }
            asm volatile("s_waitcnt vmcnt(0)" ::: "memory"); __syncthreads();
            { SchedGOwn S; S.wg = F.bx; S.A = (const char*)F.out; S.B = (const char*)(ws + WS_WG);
              EpiGate E{(const bf16*)(ar + AR_P), (bf16*)(ws + WS_Y), rstd}; pg8::gemm_phase<EpiGate, SchedGOwn, true, true, true>(F.lds, 1024, 1024, 1024, S, E); }
            SEAM(8); }
        if (IN(9)) { PHASE_ENTER(); SchedStd S; S.o.init(128, 4, F.G, F.bx); S.A = (const char*)(ws + WS_Y); S.B = (const char*)(ws + WS_WO); S.ta = (size_t)256 * 1024 * 2; S.tb = (size_t)256 * 1024 * 2;
            EpiPlain E{(bf16*)(ws + WS_BR), 1024}; pg8::gemm_phase<EpiPlain, SchedStd, true, true>(F.lds, 2048, 2048, 2048, S, E); SEAM(9); }
        if (IN(10)) { PHASE_ENTER(); norm_pass(F, (const bf16*)(ws + WS_BR), F.in[6] + l * DM, 1.0f, false, false); SEAM(10); }
        if (IN(11)) { PHASE_ENTER(); SchedStd S; S.o.init(128, 22, F.G, F.bx); S.A = xb; S.B = (const char*)(ws + WS_WGU2); S.ta = (size_t)256 * 1024 * 2; S.tb = (size_t)256 * 1024 * 2;
            EpiFfn1 E{(bf16*)(ar + AR_HID), rstd}; pg8::gemm_phase<EpiFfn1, SchedStd, true, true>(F.lds, 2048, 2048, 2048, S, E); SEAM(11); }
        if (IN(12)) { PHASE_ENTER(); SchedStd S; S.o.init(128, 4, F.G, F.bx); S.A = (const char*)(ar + AR_HID); S.B = (const char*)(ws + WS_WD2); S.ta = (size_t)256 * FF * 2; S.tb = (size_t)256 * FF * 2;
            EpiPlain E{(bf16*)(ar + AR_HB), 1024}; pg8::gemm_phase<EpiPlain, SchedStd, true, true>(F.lds, FF * 2, FF * 2, FF * 2, S, E); SEAM(12); }
        if (IN(13)) { PHASE_ENTER(); norm_pass(F, (const bf16*)(ar + AR_HB), F.in[20] + l * DM, 0.5f, false, l == DEPTH - 1); if (!single && l + 1 < args.layer_hi) { convert_layer(F, l + 1); xcd_barrier(bar); } }
    }
#undef IN
#undef SEAM
}

extern "C" void kernel_launch(void* const* d_in, const int* in_sizes, int n_in, void* d_out, int out_size, void* d_ws, size_t ws_size, hipStream_t stream) {
    static int grid = 0;
    if (grid == 0) {
        if (n_in != 24 || out_size != M * DM || ws_size < WS_END) { fprintf(stderr, "kernel_launch: unexpected shapes (n_in %d out %d ws %zu)\n", n_in, out_size, ws_size); grid = -1; return; }
        int dev = 0, cus = 0, per_cu = 0;
        if (hipGetDevice(&dev) != hipSuccess || hipDeviceGetAttribute(&cus, hipDeviceAttributeMultiprocessorCount, dev) != hipSuccess) { grid = -1; return; }
        if (hipFuncSetAttribute((const void*)mega_fwd, hipFuncAttributeMaxDynamicSharedMemorySize, LDS_BYTES) != hipSuccess) { fprintf(stderr, "kernel_launch: hipFuncSetAttribute failed\n"); grid = -1; return; }
        if (hipOccupancyMaxActiveBlocksPerMultiprocessor(&per_cu, (const void*)mega_fwd, 512, LDS_BYTES) != hipSuccess || per_cu < 1) fprintf(stderr, "kernel_launch: occupancy query says %d\n", per_cu);
        (void)hipGetLastError();
        grid = cus < 256 ? cus : 256;
    }
    if (grid < 0) return;
    (void)hipMemsetAsync((char*)d_ws + WS_CTL, 0, CTL_ZERO_BYTES, stream);
    Args a{};
    for (int i = 0; i < 24; ++i) a.in[i] = (const float*)d_in[i];
    a.out = (float*)d_out; a.ws = (unsigned char*)d_ws;
    a.ph_lo = 0; a.ph_hi = NPH; a.layer_lo = 0; a.layer_hi = DEPTH;
    hipLaunchKernelGGL(mega_fwd, dim3(grid), dim3(512), LDS_BYTES, stream, a);
    const hipError_t le = hipPeekAtLastError();
    if (le != hipSuccess) fprintf(stderr, "kernel_launch: launch failed: %s\n", hipGetErrorName(le));
}
```

```cpp
#include <hip/hip_runtime.h>
#include <cstdio>
#include <cstdint>

#define GAS __attribute__((address_space(1)))
#define LAS __attribute__((address_space(3)))
typedef unsigned short bf16;
typedef short bf16x8 __attribute__((ext_vector_type(8)));
typedef float f32x4 __attribute__((ext_vector_type(4)));
typedef float f32x16 __attribute__((ext_vector_type(16)));
typedef unsigned u32x4 __attribute__((ext_vector_type(4)));
typedef unsigned u32x2 __attribute__((ext_vector_type(2)));
typedef GAS unsigned gu32;
#define RLX_AGENT __ATOMIC_RELAXED, __HIP_MEMORY_SCOPE_AGENT

constexpr int NB = 4, SEQ = 8192, DM = 1024, M = NB * SEQ, FF = 2816, DEPTH = 4;
constexpr int ZW = 2048;
constexpr int ZU = 0, ZV = 256, ZP = 512, ZQ = 768, ZK = 1024, ZA = 1280, ZG = 1536;
constexpr float EPS = 1e-6f;
constexpr float LOG2E = 1.4426950408889634f;
constexpr float QSCALE = 0.125f * LOG2E;
constexpr float IDX_SCALE = 0.5f * 0.17677669529663687f;

constexpr size_t MiB = 1u << 20;
constexpr size_t WS_CTL = 0, CTL_ZERO_BYTES = 32 * 1024;
constexpr size_t WS_RSTD = 1 * MiB;
constexpr size_t WS_WSB = 1 * MiB + 256 * 1024;
constexpr size_t WS_PWT = 1 * MiB + 512 * 1024;
constexpr size_t WS_WGU1 = 2 * MiB, WS_WD1 = 13 * MiB, WS_WGU2 = 18 * MiB + 512 * 1024, WS_WD2 = 29 * MiB + 512 * 1024;
constexpr size_t WS_WZ = 35 * MiB, WS_WG = 39 * MiB + 512 * 1024, WS_WB = 47 * MiB + 512 * 1024, WS_WO = 49 * MiB + 512 * 1024;
constexpr size_t WS_XB = 52 * MiB;
constexpr size_t WS_BR = 116 * MiB;
constexpr size_t WS_Y = 180 * MiB;
constexpr size_t WS_AR = 244 * MiB;
constexpr size_t WS_END = 500 * MiB;
constexpr size_t AR_Z = 0, AR_QI = 128 * MiB, AR_KI = 136 * MiB, AR_WI = 138 * MiB, AR_VT = 139 * MiB, AR_M8 = 155 * MiB;
constexpr size_t AR_KC = 188 * MiB;
constexpr size_t AR_HID = 0, AR_HB = 176 * MiB;
constexpr size_t AR_P = 0;
static_assert(WS_WG == WS_WZ + (size_t)2304 * 1024 * 2, "Wz and Wg contiguous");
static_assert(AR_M8 + (size_t)NB * 128 * SEQ * 8 <= 256 * MiB, "arena");

constexpr int CW_TMO = 0;
constexpr int CW_BAR = 4096;

constexpr int LDS_BYTES = 147456;
constexpr int MISC_OFF = 140 * 1024;
constexpr int NWAVES = 8;

#define LDS_WAIT() asm volatile("s_waitcnt lgkmcnt(0)" ::: "memory")
#define VM_WAIT() asm volatile("s_waitcnt vmcnt(0)" ::: "memory")
__device__ __forceinline__ unsigned f2bf(float f) { unsigned u = __builtin_bit_cast(unsigned, f); return (u + 0x7fffu + ((u >> 16) & 1u)) >> 16; }
typedef __bf16 bf16x2_t __attribute__((ext_vector_type(2)));
typedef float f32x2_t __attribute__((ext_vector_type(2)));
__device__ __forceinline__ unsigned pk2(float lo, float hi) { const f32x2_t v = {lo, hi}; const bf16x2_t b = __builtin_convertvector(v, bf16x2_t); return __builtin_bit_cast(unsigned, b); }
__device__ __forceinline__ float bf2f(unsigned short b) { return __builtin_bit_cast(float, (unsigned)b << 16); }
__device__ __forceinline__ float bflo(unsigned w) { return __builtin_bit_cast(float, w << 16); }
__device__ __forceinline__ float bfhi(unsigned w) { return __builtin_bit_cast(float, w & 0xffff0000u); }
__device__ __forceinline__ float fast_exp2(float x) { return __builtin_amdgcn_exp2f(x); }
__device__ __forceinline__ float fast_rcp(float x) { return __builtin_amdgcn_rcpf(x); }
__device__ __forceinline__ float sigmoidf_(float x) { return fast_rcp(1.0f + fast_exp2(-x * LOG2E)); }
__device__ __forceinline__ float siluf_(float x) { return x * sigmoidf_(x); }
__device__ __forceinline__ float swiglu2(float gp, float up) { return (gp * up) * fast_rcp(1.0f + fast_exp2(-gp)); }
__device__ __forceinline__ float gelu_tanh(float x) { const float u = 0.7978845608028654f * (x + 0.044715f * x * x * x); return x * fast_rcp(1.0f + fast_exp2(-2.0f * LOG2E * u)); }
template <int CTRL> __device__ __forceinline__ float dpp_perm(float v) { return __builtin_bit_cast(float, __builtin_amdgcn_update_dpp(0, __builtin_bit_cast(int, v), CTRL, 0xf, 0xf, true)); }
__device__ __forceinline__ float wave_sum(float v) {
    v += dpp_perm<0xB1>(v);
    v += dpp_perm<0x4E>(v);
    v += dpp_perm<0x141>(v);
    v += dpp_perm<0x140>(v);
    const int b = __builtin_bit_cast(int, v);
    const float r0 = __builtin_bit_cast(float, __builtin_amdgcn_readlane(b, 0)), r1 = __builtin_bit_cast(float, __builtin_amdgcn_readlane(b, 16));
    const float r2 = __builtin_bit_cast(float, __builtin_amdgcn_readlane(b, 32)), r3 = __builtin_bit_cast(float, __builtin_amdgcn_readlane(b, 48));
    return (r0 + r1) + (r2 + r3);
}

#define XB_TMO      128
#define XB_XCNT(j)  (256  + 64 * (j))
#define XB_XSUB(j)  (1280 + 64 * (j))
#define XB_XGEN(j)  (2304 + 64 * (j))
#define XB_TOP      3328
#define XB_TOPGEN   3392
#define XCD_BAR_WORDS 3456
#define XB_SPIN_CAP (1u << 22)
__device__ __forceinline__ unsigned xb_ld(unsigned* p)              { return __hip_atomic_load(p, __ATOMIC_RELAXED, __HIP_MEMORY_SCOPE_AGENT); }
__device__ __forceinline__ unsigned xb_add(unsigned* p, unsigned v) { return __hip_atomic_fetch_add(p, v, __ATOMIC_RELAXED, __HIP_MEMORY_SCOPE_AGENT); }
__device__ __forceinline__ unsigned xb_xcc_id() { return (unsigned)__builtin_amdgcn_s_getreg((3 << 11) | 20) & 0xFu; }
#define XB_SPIN(cond, bar) do { unsigned _sp = 0; while (cond) { __builtin_amdgcn_s_sleep(1); \
    if ((++_sp & 255u) == 0u) { if (xb_ld(&(bar)[XB_TMO])) break; if (_sp > XB_SPIN_CAP) { atomicAdd(&(bar)[XB_TMO], 1u); break; } } } } while (0)
struct XcdBarrier { unsigned* bar; unsigned x; volatile LAS unsigned* st; };
__device__ __forceinline__ XcdBarrier xcd_barrier_post(unsigned* bar, volatile LAS unsigned* st) {
    XcdBarrier b; b.bar = bar; b.x = xb_xcc_id(); b.st = st;
    if (threadIdx.x == 0) (void)xb_add(&bar[XB_XCNT(b.x)], 1u);
    return b;
}
__device__ __forceinline__ void xcd_barrier_complete(unsigned* bar, unsigned x, unsigned& nloc, unsigned& nx) {
    const unsigned G = gridDim.x * gridDim.y * gridDim.z;
    unsigned sum, cnt, mine, sp = 0u;
    for (;;) {
        sum = 0u; cnt = 0u; mine = 0u;
#pragma unroll
        for (unsigned j = 0; j < 16; ++j) { const unsigned c = xb_ld(&bar[XB_XCNT(j)]); sum += c; cnt += (c > 0u) ? 1u : 0u; mine = (j == x) ? c : mine; }
        if (sum == G) break;
        __builtin_amdgcn_s_sleep(1);
        if ((++sp & 255u) == 0u) { if (xb_ld(&bar[XB_TMO])) break; if (sp > XB_SPIN_CAP) { atomicAdd(&bar[XB_TMO], 1u); break; } }
    }
    nloc = mine > 0u ? mine : 1u; nx = cnt > 0u ? cnt : 1u;
}
__device__ __forceinline__ void xcd_barrier(const XcdBarrier& b) {
    asm volatile("s_waitcnt vmcnt(0)" ::: "memory");
    __syncthreads();
    if (threadIdx.x == 0) {
        unsigned* bar = b.bar;
        __builtin_amdgcn_s_waitcnt(0);
        unsigned nloc = b.st[0], nx = b.st[1];
        if (nloc == 0u) { xcd_barrier_complete(bar, b.x, nloc, nx); b.st[0] = nloc; b.st[1] = nx; }
        const unsigned old = xb_add(&bar[XB_XSUB(b.x)], 1u);
        const unsigned gen = old / nloc;
        if (old + 1u == (gen + 1u) * nloc) {
            __builtin_amdgcn_fence(__ATOMIC_RELEASE, "agent");
            asm volatile("s_waitcnt vmcnt(0)" ::: "memory");
            const unsigned og = xb_add(&bar[XB_TOP], 1u);
            const unsigned tg = og / nx;
            if (og + 1u == (tg + 1u) * nx) xb_add(&bar[XB_TOPGEN], 1u);
            else XB_SPIN(xb_ld(&bar[XB_TOPGEN]) == tg, bar);
            __builtin_amdgcn_fence(__ATOMIC_ACQUIRE, "agent");
            xb_add(&bar[XB_XGEN(b.x)], 1u);
            asm volatile("s_waitcnt vmcnt(0)" ::: "memory");
        } else {
            XB_SPIN(xb_ld(&bar[XB_XGEN(b.x)]) == gen, bar);
            __builtin_amdgcn_fence(__ATOMIC_ACQUIRE, "agent");
            asm volatile("s_waitcnt vmcnt(0)" ::: "memory");
        }
    }
    __syncthreads();
}

namespace pg8 {
constexpr int BM = 256, BK = 64, HALF = 128, HTB = HALF * BK * 2, STAGE_BYTES = 8 * HTB, NXCD = 8, WGM = 8;
__host__ __device__ __forceinline__ int lds_byte(int r, int c) { const int st = (r >> 4) * 2 + (c >> 5), rr = r & 15, cc = c & 31, ob = rr * 64 + cc * 2; return st * 1024 + (ob ^ (((ob >> 9) & 1) << 5)); }
__host__ __device__ __forceinline__ void stage_rc(int b, int& R, int& C) { const int st = b / 1024, sb = b % 1024, swz = sb ^ (((sb >> 9) & 1) << 5); R = (st >> 1) * 16 + swz / 64; C = (st & 1) * 32 + (swz % 64) / 2; }
__host__ __device__ __forceinline__ int perm32(int rho) { const int n = rho >> 4, i = rho & 15; return 8 * (i >> 2) + 4 * n + (i & 3); }
struct Unit { int pm, pn; };
struct StaticOrder {
    int nM, nN, nwg, G, c;
    __device__ void init(int nM_, int nN_, int G_, int c_) { nM = nM_; nN = nN_; nwg = nM * nN; G = G_; c = c_; }
    __device__ bool next(int i, Unit& u) const {
        const long L = (long)i * G + c; if (L >= nwg) return false;
        int wgid = (int)L; { const int q = nwg / NXCD, r = nwg % NXCD, xcd = wgid % NXCD, off = wgid / NXCD; wgid = (xcd < r ? xcd * (q + 1) : r * (q + 1) + (xcd - r) * q) + off; }
        const int nig = WGM * nN, gid = wgid / nig, fm = gid * WGM, gsz = ((nM & (WGM - 1)) == 0 || (nM - fm) >= WGM) ? WGM : (nM - fm);
        u.pm = fm + ((wgid % nig) % gsz); u.pn = (wgid % nig) / gsz; return true;
    }
};
typedef int i32x8 __attribute__((ext_vector_type(8)));
typedef int i32x4_ __attribute__((ext_vector_type(4)));
template <class Epi, class Sched, bool ALIGN_EPI, bool SP2, bool FP8 = false>
__device__ __forceinline__ void gemm_phase(LAS unsigned char* lds, const int Kb, const int ldab, const int ldbb, const Sched& S, const Epi& E) {
    int tid_l = threadIdx.x; asm volatile("" : "+v"(tid_l));
    const int tid = tid_l, wid = __builtin_amdgcn_readfirstlane(tid >> 6), lane = tid & 63, wr = wid >> 2, wc = wid & 3, fr = lane & 15, fq = lane >> 4;
    const int nt = Kb / (BK * 2);
    unsigned voffA[2], voffB[2];
#pragma unroll
    for (int i = 0; i < 2; ++i) { int R, C; stage_rc(tid * 16 + i * 8192, R, C); const int Rb = Epi::PERM ? ((R & ~31) + perm32(R & 31)) : R; voffA[i] = (unsigned)(R * ldab + C * 2); voffB[i] = (unsigned)(Rb * ldbb + C * 2); }
    const size_t kstep = (size_t)(BK * 2);
    const size_t hstepA = (size_t)HALF * ldab, hstepB = (size_t)HALF * ldbb;
    const unsigned ldsw = (unsigned)wid * 1024u;
    const int aoff = lds_byte(wr * 64 + fr, fq * 8), boff = lds_byte(wc * 32 + fr, fq * 8);
#define PG8_SA(b, h) (((b) * 2 + (h)) * HTB)
#define PG8_SB(b, h) ((4 + (b) * 2 + (h)) * HTB)
#define PG8_STAGE(bufoff, gbase, voff) do { _Pragma("unroll") for (int _i = 0; _i < 2; ++_i) \
        __builtin_amdgcn_global_load_lds((const unsigned*)((const char*)(gbase) + (voff)[_i]), (LAS unsigned*)(lds + (bufoff) + ldsw + _i * 8192), 16, 0, 0); } while (0)
#define PG8_LDA(dst, b, h) do { _Pragma("unroll") for (int m = 0; m < 4; ++m) _Pragma("unroll") for (int k = 0; k < 2; ++k) dst[m][k] = *(const LAS bf16x8*)(lds + PG8_SA(b, h) + aoff + m * 2048 + k * 1024); } while (0)
#define PG8_LDB(dst, b, h) do { _Pragma("unroll") for (int n = 0; n < 2; ++n) _Pragma("unroll") for (int k = 0; k < 2; ++k) dst[n][k] = *(const LAS bf16x8*)(lds + PG8_SB(b, h) + boff + n * 2048 + k * 1024); } while (0)
#define PG8_CAT(x) __builtin_shufflevector(__builtin_bit_cast(i32x4_, (x)[0]), __builtin_bit_cast(i32x4_, (x)[1]), 0, 1, 2, 3, 4, 5, 6, 7)
#define PG8_MMA(ai, bj, At, Bt) do { __builtin_amdgcn_s_setprio(1); _Pragma("unroll") for (int m = 0; m < 4; ++m) _Pragma("unroll") for (int n = 0; n < 2; ++n) { \
        if constexpr (FP8) asm volatile("v_mfma_f32_16x16x128_f8f6f4 %0, %1, %2, %0" : "+v"(acc[ai][bj][m][n]) : "v"(PG8_CAT(Bt[n])), "v"(PG8_CAT(At[m]))); \
        else { _Pragma("unroll") for (int k = 0; k < 2; ++k) acc[ai][bj][m][n] = __builtin_amdgcn_mfma_f32_16x16x32_bf16(Bt[n][k], At[m][k], acc[ai][bj][m][n], 0, 0, 0); } } __builtin_amdgcn_s_setprio(0); } while (0)
#define PG8_WAIT_V(n) asm volatile("s_waitcnt vmcnt(" #n ")" ::: "memory")
#define PG8_WAIT_L(n) asm volatile("s_waitcnt lgkmcnt(" #n ")" ::: "memory")
#define PG8_BAR __builtin_amdgcn_s_barrier()
#define PG8_SCHED __builtin_amdgcn_sched_barrier(0)
    Unit cur, nxt; int ui = 0;
    if (!S.next(0, cur)) return;
    f32x4 acc[2][2][4][2];
#pragma unroll
    for (int a = 0; a < 2; ++a)
#pragma unroll
        for (int b = 0; b < 2; ++b)
#pragma unroll
            for (int m = 0; m < 4; ++m)
#pragma unroll
                for (int n = 0; n < 2; ++n) acc[a][b][m][n] = (f32x4){0.f, 0.f, 0.f, 0.f};
    bf16x8 At[4][2], B0[2][2], B1[2][2];
    const char* cA = S.a_base(cur); const char* cB = S.b_base(cur);
    if constexpr (SP2) {
        PG8_STAGE(PG8_SB(0, 0), cB, voffB); PG8_STAGE(PG8_SB(0, 1), cB + hstepB, voffB); PG8_STAGE(PG8_SA(0, 0), cA, voffA); PG8_STAGE(PG8_SA(0, 1), cA + hstepA, voffA);
        if (wr == 1) PG8_BAR;
        PG8_WAIT_V(2); PG8_BAR;
        PG8_STAGE(PG8_SB(1, 0), cB + kstep, voffB); PG8_STAGE(PG8_SA(1, 0), cA + kstep, voffA); PG8_STAGE(PG8_SB(1, 1), cB + hstepB + kstep, voffB);
        PG8_WAIT_V(6); PG8_BAR;
    } else {
        PG8_STAGE(PG8_SB(0, 0), cB, voffB); PG8_STAGE(PG8_SA(0, 0), cA, voffA); PG8_STAGE(PG8_SB(0, 1), cB + hstepB, voffB); PG8_STAGE(PG8_SA(0, 1), cA + hstepA, voffA);
        if (wr == 1) PG8_BAR;
        PG8_WAIT_V(4); PG8_BAR;
        PG8_STAGE(PG8_SB(1, 0), cB + kstep, voffB); PG8_STAGE(PG8_SA(1, 0), cA + kstep, voffA); PG8_STAGE(PG8_SB(1, 1), cB + hstepB + kstep, voffB);
        PG8_WAIT_V(6); PG8_BAR;
    }
    for (;;) {
        const bool has_next = S.next(ui + 1, nxt);
        const char* nA = has_next ? S.a_base(nxt) : cA; const char* nB = has_next ? S.b_base(nxt) : cB;
#pragma clang loop unroll(disable)
        for (int t = 0; t < nt; t += 2) {
            const bool last = (t == nt - 2);
            const char* a1 = cA + (size_t)(t + 1) * kstep;
            const char* a2 = last ? nA : cA + (size_t)(t + 2) * kstep; const char* b2 = last ? nB : cB + (size_t)(t + 2) * kstep;
            const char* a3 = a2 + kstep; const char* b3 = b2 + kstep;
            if constexpr (SP2) {
            PG8_LDB(B0, 0, 0); PG8_LDB(B1, 0, 1); PG8_SCHED; PG8_LDA(At, 0, 0); PG8_STAGE(PG8_SA(1, 1), a1 + hstepA, voffA);
            PG8_WAIT_V(8); PG8_WAIT_L(0); PG8_BAR; PG8_MMA(0, 0, At, B0); PG8_MMA(0, 1, At, B1); PG8_BAR; PG8_SCHED;
            PG8_LDA(At, 0, 1); PG8_STAGE(PG8_SB(0, 0), b2, voffB); PG8_STAGE(PG8_SB(0, 1), b2 + hstepB, voffB); PG8_STAGE(PG8_SA(0, 0), a2, voffA);
            PG8_WAIT_V(8); PG8_WAIT_L(0); PG8_BAR; PG8_MMA(1, 0, At, B0); PG8_MMA(1, 1, At, B1); PG8_BAR; PG8_SCHED;
            PG8_LDB(B0, 1, 0); PG8_LDB(B1, 1, 1); PG8_SCHED; PG8_LDA(At, 1, 0); PG8_STAGE(PG8_SA(0, 1), a2 + hstepA, voffA);
            PG8_WAIT_V(8); PG8_WAIT_L(0); PG8_BAR; PG8_MMA(0, 0, At, B0); PG8_MMA(0, 1, At, B1); PG8_BAR; PG8_SCHED;
            PG8_LDA(At, 1, 1); PG8_STAGE(PG8_SB(1, 0), b3, voffB); PG8_STAGE(PG8_SB(1, 1), b3 + hstepB, voffB); PG8_STAGE(PG8_SA(1, 0), a3, voffA);
            PG8_WAIT_V(8); PG8_WAIT_L(0); PG8_BAR; PG8_MMA(1, 0, At, B0); PG8_MMA(1, 1, At, B1); PG8_BAR; PG8_SCHED;
            } else {
            PG8_LDB(B0, 0, 0); PG8_SCHED; PG8_LDA(At, 0, 0); PG8_STAGE(PG8_SA(1, 1), a1 + hstepA, voffA);
            PG8_WAIT_L(8); PG8_BAR; PG8_WAIT_L(0); PG8_MMA(0, 0, At, B0); PG8_BAR; PG8_SCHED;
            PG8_LDB(B1, 0, 1); PG8_STAGE(PG8_SB(0, 0), b2, voffB);
            PG8_BAR; PG8_WAIT_L(0); PG8_MMA(0, 1, At, B1); PG8_BAR;
            PG8_LDA(At, 0, 1); PG8_STAGE(PG8_SA(0, 0), a2, voffA);
            PG8_BAR; PG8_WAIT_L(0); PG8_MMA(1, 0, At, B0); PG8_BAR; PG8_SCHED;
            PG8_STAGE(PG8_SB(0, 1), b2 + hstepB, voffB);
            PG8_WAIT_V(6); PG8_BAR; PG8_MMA(1, 1, At, B1); PG8_BAR;
            PG8_LDB(B0, 1, 0); PG8_SCHED; PG8_LDA(At, 1, 0); PG8_STAGE(PG8_SA(0, 1), a2 + hstepA, voffA);
            PG8_WAIT_L(8); PG8_BAR; PG8_WAIT_L(0); PG8_MMA(0, 0, At, B0); PG8_BAR; PG8_SCHED;
            PG8_LDB(B1, 1, 1); PG8_STAGE(PG8_SB(1, 0), b3, voffB);
            PG8_BAR; PG8_WAIT_L(0); PG8_MMA(0, 1, At, B1); PG8_BAR;
            PG8_LDA(At, 1, 1); PG8_STAGE(PG8_SA(1, 0), a3, voffA);
            PG8_BAR; PG8_WAIT_L(0); PG8_MMA(1, 0, At, B0); PG8_BAR; PG8_SCHED;
            PG8_STAGE(PG8_SB(1, 1), b3 + hstepB, voffB);
            PG8_WAIT_V(6); PG8_BAR; PG8_MMA(1, 1, At, B1); PG8_BAR;
            }
        }
        if constexpr (ALIGN_EPI) { if (wr == 0) PG8_BAR; }
        if constexpr (FP8) {
#pragma unroll
            for (int a = 0; a < 2; ++a)
#pragma unroll
                for (int b = 0; b < 2; ++b)
                    asm volatile("s_nop 15\n\ts_nop 7" : "+v"(acc[a][b][0][0]), "+v"(acc[a][b][0][1]), "+v"(acc[a][b][1][0]), "+v"(acc[a][b][1][1]), "+v"(acc[a][b][2][0]), "+v"(acc[a][b][2][1]), "+v"(acc[a][b][3][0]), "+v"(acc[a][b][3][1])); }
        { Unit eu = cur; int e_fr = fr, e_fq = fq, e_wr = wr, e_wc = wc;
          asm volatile("" : "+s"(eu.pm), "+s"(eu.pn), "+v"(e_fr), "+v"(e_fq), "+s"(e_wr), "+s"(e_wc));
          Epi e2 = E; if constexpr (FP8) e2.launder(); e2(acc, eu, e_wr, e_wc, e_fr, e_fq); }
        if (!has_next) break;
#pragma unroll
        for (int a = 0; a < 2; ++a)
#pragma unroll
            for (int b = 0; b < 2; ++b)
#pragma unroll
                for (int m = 0; m < 4; ++m)
#pragma unroll
                    for (int n = 0; n < 2; ++n) { typedef double d64x2 __attribute__((ext_vector_type(2))); d64x2 z; asm volatile("v_mov_b64 %0, 0" : "=v"(z.x)); asm volatile("v_mov_b64 %0, 0" : "=v"(z.y)); acc[a][b][m][n] = __builtin_bit_cast(f32x4, z); }
        cur = nxt; cA = nA; cB = nB; ++ui;
        if constexpr (ALIGN_EPI) { if (wr == 1) PG8_BAR; }
    }
    PG8_WAIT_V(0);
    if constexpr (!ALIGN_EPI) { if (wr == 0) PG8_BAR; }
    PG8_BAR;
#undef PG8_SA
#undef PG8_SB
#undef PG8_STAGE
#undef PG8_LDA
#undef PG8_LDB
#undef PG8_MMA
#undef PG8_CAT
#undef PG8_WAIT_V
#undef PG8_WAIT_L
#undef PG8_BAR
#undef PG8_SCHED
}
}

struct SchedStd {
    pg8::StaticOrder o; const char* A; const char* B; size_t ta, tb;
    __device__ __forceinline__ bool next(int i, pg8::Unit& u) const { return o.next(i, u); }
    __device__ __forceinline__ const char* a_base(const pg8::Unit& u) const { return A + (size_t)u.pm * ta; }
    __device__ __forceinline__ const char* b_base(const pg8::Unit& u) const { return B + (size_t)u.pn * tb; }
};
__device__ __forceinline__ int ztile(int slot) { return slot < 5 ? slot : (slot < 7 ? slot + 2 : slot - 2); }
struct SchedZ {
    pg8::StaticOrder o; const char* X; const char* W;
    __device__ __forceinline__ bool next(int i, pg8::Unit& u) const { return o.next(i, u); }
    __device__ __forceinline__ const char* a_base(const pg8::Unit& u) const { return ztile(u.pn) == 8 ? W + (size_t)8 * 256 * 1024 * 2 : X + (size_t)u.pm * 256 * 1024 * 2; }
    __device__ __forceinline__ const char* b_base(const pg8::Unit& u) const { return ztile(u.pn) == 8 ? X + (size_t)u.pm * 256 * 1024 * 2 : W + (size_t)ztile(u.pn) * 256 * 1024 * 2; }
};
struct SchedP {
    pg8::StaticOrder o; const char* A; const char* B;
    __device__ __forceinline__ bool next(int i, pg8::Unit& u) const { return o.next(i, u); }
    __device__ __forceinline__ const char* a_base(const pg8::Unit& u) const { return A + (size_t)u.pm * 256 * 1024 * 2 + (size_t)(u.pn >> 2) * 512; }
    __device__ __forceinline__ const char* b_base(const pg8::Unit& u) const { return B + (size_t)u.pn * 256 * 256 * 2; }
};

struct SchedPOwn {
    int wg, G; const char* A; const char* B;
    __device__ __forceinline__ bool next(int i, pg8::Unit& u) const { if (i >= 8 || wg >= 256) return false; u.pm = wg >> 1; u.pn = 4 * (i >> 1) + 2 * (wg & 1) + (i & 1); return true; }
    __device__ __forceinline__ const char* a_base(const pg8::Unit& u) const { return A + (size_t)u.pm * 256 * 1024 * 2 + (size_t)(u.pn >> 2) * 512; }
    __device__ __forceinline__ const char* b_base(const pg8::Unit& u) const { return B + (size_t)u.pn * 256 * 256 * 2; }
};
struct SchedGOwn {
    int wg; const char* A; const char* B;
    __device__ __forceinline__ bool next(int i, pg8::Unit& u) const { if (i >= 8 || wg >= 256) return false; u.pm = wg >> 1; u.pn = 8 * (wg & 1) + i; return true; }
    __device__ __forceinline__ const char* a_base(const pg8::Unit& u) const { return A + (size_t)u.pm * 256 * 1024; }
    __device__ __forceinline__ const char* b_base(const pg8::Unit& u) const { return B + (size_t)u.pn * 256 * 1024; }
};
typedef f32x4 AccT[2][2][4][2];
struct EpiFfn1 {
    static constexpr bool PERM = true;
    bf16* H;
    __device__ __forceinline__ void launder() { size_t z = 0; asm volatile("" : "+s"(z)); H += z; }
    __device__ __forceinline__ void operator()(const AccT& acc, const pg8::Unit& u, int wr, int wc, int fr, int fq) const {
#pragma unroll
        for (int ai = 0; ai < 2; ++ai)
#pragma unroll
            for (int m = 0; m < 4; ++m) {
                const int row = u.pm * 256 + ai * 128 + wr * 64 + m * 16 + fr; const float rs = 1.0f;
                bf16* hp = H + (size_t)row * FF + u.pn * 128 + wc * 32 + fq * 8;
                const f32x4 g0 = acc[ai][0][m][0] * rs, g1 = acc[ai][0][m][1] * rs, u0 = acc[ai][1][m][0] * rs, u1 = acc[ai][1][m][1] * rs;
                u32x4 w; w.x = pk2(swiglu2(g0[0], u0[0]), swiglu2(g0[1], u0[1])); w.y = pk2(swiglu2(g0[2], u0[2]), swiglu2(g0[3], u0[3]));
                w.z = pk2(swiglu2(g1[0], u1[0]), swiglu2(g1[1], u1[1])); w.w = pk2(swiglu2(g1[2], u1[2]), swiglu2(g1[3], u1[3]));
                *(u32x4*)hp = w; }
    }
};
struct EpiPlain {
    static constexpr bool PERM = true;
    bf16* O; int ldc;
    __device__ __forceinline__ void launder() { size_t z = 0; asm volatile("" : "+s"(z)); O += z; }
    __device__ __forceinline__ void operator()(const AccT& acc, const pg8::Unit& u, int wr, int wc, int fr, int fq) const {
#pragma unroll
        for (int ai = 0; ai < 2; ++ai)
#pragma unroll
            for (int m = 0; m < 4; ++m) {
                const int row = u.pm * 256 + ai * 128 + wr * 64 + m * 16 + fr;
                bf16* op = O + (size_t)row * ldc + u.pn * 256 + wc * 32 + fq * 8;
#pragma unroll
                for (int bj = 0; bj < 2; ++bj) { const f32x4 v0 = acc[ai][bj][m][0], v1 = acc[ai][bj][m][1];
                    u32x4 w; w.x = pk2(v0[0], v0[1]); w.y = pk2(v0[2], v0[3]); w.z = pk2(v1[0], v1[1]); w.w = pk2(v1[2], v1[3]); *(u32x4*)(op + bj * 128) = w; } }
    }
};
struct EpiZ {
    static constexpr bool PERM = true;
    unsigned char* ar;
    __device__ __forceinline__ void launder() { size_t z = 0; asm volatile("" : "+s"(z)); ar += z; }
    __device__ __forceinline__ void operator()(const AccT& acc, const pg8::Unit& u, int wr, int wc, int fr, int fq) const {
        bf16* Z = (bf16*)(ar + AR_Z); bf16* QI = (bf16*)(ar + AR_QI); bf16* KI = (bf16*)(ar + AR_KI); float* WI = (float*)(ar + AR_WI); bf16* VT = (bf16*)(ar + AR_VT); bf16* KC = (bf16*)(ar + AR_KC);
        if (ztile(u.pn) == 8) {
#pragma unroll
            for (int bj = 0; bj < 2; ++bj) {
                const int tok = u.pm * 256 + bj * 128 + wc * 32 + fq * 8; const float rs0 = 1.0f, rs1 = 1.0f;
#pragma unroll
                for (int ai = 0; ai < 2; ++ai)
#pragma unroll
                    for (int m = 0; m < 4; ++m) { const int c = ai * 128 + wr * 64 + m * 16 + fr; const f32x4 v0 = acc[ai][bj][m][0] * rs0, v1 = acc[ai][bj][m][1] * rs1;
                        const int g0 = tok & ~15, hf = (tok >> 3) & 1;
                        u32x2 wa, wb; wa.x = pk2(v0[0], v0[1]); wa.y = pk2(v0[2], v0[3]); wb.x = pk2(v1[0], v1[1]); wb.y = pk2(v1[2], v1[3]);
                        const int bb = g0 >> 13, tt = g0 & 8191;
                        bf16* vp = VT + ((((size_t)(bb * 4 + (c >> 6)) * 128 + (tt >> 6)) * 64 + (c & 63)) * 64) + (tt & 63);
                        *(u32x2*)(vp + (hf ? 4 : 0)) = wa; *(u32x2*)(vp + (hf ? 12 : 8)) = wb; } }
            return;
        }
        const int pn = ztile(u.pn);
#pragma unroll
        for (int ai = 0; ai < 2; ++ai)
#pragma unroll
            for (int m = 0; m < 4; ++m) {
                const int row = u.pm * 256 + ai * 128 + wr * 64 + m * 16 + fr; const float rs = 1.0f;
#pragma unroll
                for (int bj = 0; bj < 2; ++bj) {
                    const int cl = bj * 128 + wc * 32 + fq * 8;
                    f32x4 v0 = acc[ai][bj][m][0] * rs, v1 = acc[ai][bj][m][1] * rs;
                    if (pn < 2) { v0[0] = gelu_tanh(v0[0]); v0[1] = gelu_tanh(v0[1]); v0[2] = gelu_tanh(v0[2]); v0[3] = gelu_tanh(v0[3]); v1[0] = gelu_tanh(v1[0]); v1[1] = gelu_tanh(v1[1]); v1[2] = gelu_tanh(v1[2]); v1[3] = gelu_tanh(v1[3]); }
                    else if (pn == 3) { v0 = v0 * QSCALE; v1 = v1 * QSCALE; }
                    u32x4 w; w.x = pk2(v0[0], v0[1]); w.y = pk2(v0[2], v0[3]); w.z = pk2(v1[0], v1[1]); w.w = pk2(v1[2], v1[3]);
                    if (pn == 7) {
                        if (cl < 128) *(u32x4*)(QI + (size_t)row * 128 + cl) = w;
                        else if (cl < 160) *(u32x4*)(KI + (size_t)row * 32 + (cl - 128)) = w;
                        else if (cl == 160) *(f32x4*)(WI + (size_t)row * 4) = v0;
                    } else if (pn == 4) { const int bb = row >> 13, tt = row & 8191; *(u32x4*)(KC + (((size_t)(bb * 4 + (cl >> 6)) * SEQ + tt) * 64) + (cl & 63)) = w; }
                    else *(u32x4*)(Z + (size_t)row * ZW + pn * 256 + cl) = w;
                } }
    }
};
struct EpiGate {
    static constexpr bool PERM = false;
    const bf16* P; bf16* Y;
    __device__ __forceinline__ void launder() { size_t z = 0; asm volatile("" : "+s"(z)); P += z; Y += z; }
    __device__ __forceinline__ void operator()(const AccT& acc, const pg8::Unit& u, int wr, int wc, int fr, int fq) const {
#pragma unroll
        for (int ai = 0; ai < 2; ++ai)
#pragma unroll
            for (int m = 0; m < 4; ++m) {
                const int row = u.pm * 256 + ai * 128 + wr * 64 + m * 16 + fr; const float rs = (1.f / 64.f);
                const int j = u.pn * 64 + wc * 16 + fq * 4;
                const bf16* pp = P + (size_t)row * 4096 + j;
                f32x4 y = (f32x4){0.f, 0.f, 0.f, 0.f};
#pragma unroll
                for (int bj = 0; bj < 2; ++bj)
#pragma unroll
                    for (int n = 0; n < 2; ++n) { const u32x2 pw = *(const u32x2*)(pp + (2 * bj + n) * 1024); const f32x4 e = acc[ai][bj][m][n] * (-rs * LOG2E);
                        y[0] += fast_rcp(1.0f + fast_exp2(e[0])) * bflo(pw.x); y[1] += fast_rcp(1.0f + fast_exp2(e[1])) * bfhi(pw.x); y[2] += fast_rcp(1.0f + fast_exp2(e[2])) * bflo(pw.y); y[3] += fast_rcp(1.0f + fast_exp2(e[3])) * bfhi(pw.y); }
                u32x2 w; w.x = pk2(y[0], y[1]); w.y = pk2(y[2], y[3]); *(u32x2*)(Y + (size_t)row * 1024 + j) = w; }
    }
};

struct Frame {
    LAS unsigned char* lds;
    int tid, lane, wave, G, bx;
    unsigned char* ws;
    const float* in[24];
    float* out;
};

template <class RM, int SPLIT8 = 0>
__device__ __forceinline__ void cvt_item(const float* W, int N, const float* gain, bf16* WT, int ldk, LAS float* scr, int kb, int nb, int lane, RM rm, unsigned char* WT8 = nullptr) {
    const int k0 = 64 * kb, n0 = 32 * nb; const int n4 = n0 + (lane & 7) * 4;
    f32x4 v[8]; float g[8];
#pragma unroll
    for (int i = 0; i < 8; ++i) { const int kk = (lane >> 3) + 8 * i; v[i] = (n4 < N) ? *(const f32x4*)(W + (size_t)(k0 + kk) * N + n4) : (f32x4){0.f, 0.f, 0.f, 0.f}; g[i] = gain ? gain[k0 + kk] : 1.f; }
#pragma unroll
    for (int i = 0; i < 8; ++i) { const int kk = (lane >> 3) + 8 * i; LAS float* d = scr + kk * 33 + (lane & 7) * 4; const f32x4 x = v[i] * (g[i] * rm.scale(n4)); d[0] = x[0]; d[1] = x[1]; d[2] = x[2]; d[3] = x[3]; }
    LDS_WAIT(); asm volatile("" ::: "memory");
    const int c = lane & 7;
#pragma unroll
    for (int j = 0; j < 4; ++j) { const int nl = (lane >> 3) + 8 * j; const int nn = n0 + nl; const int row = (nn < N) ? rm(nn) : -1; const LAS float* s = scr + (8 * c) * 33 + nl;
        u32x4 o; o.x = pk2(s[0 * 33], s[1 * 33]); o.y = pk2(s[2 * 33], s[3 * 33]); o.z = pk2(s[4 * 33], s[5 * 33]); o.w = pk2(s[6 * 33], s[7 * 33]);
        if (SPLIT8 > 0 && row >= SPLIT8) {
            int q0 = 0, q1 = 0; q0 = __builtin_amdgcn_cvt_pk_fp8_f32(s[0 * 33] * 64.f, s[1 * 33] * 64.f, q0, false); q0 = __builtin_amdgcn_cvt_pk_fp8_f32(s[2 * 33] * 64.f, s[3 * 33] * 64.f, q0, true);
            q1 = __builtin_amdgcn_cvt_pk_fp8_f32(s[4 * 33] * 64.f, s[5 * 33] * 64.f, q1, false); q1 = __builtin_amdgcn_cvt_pk_fp8_f32(s[6 * 33] * 64.f, s[7 * 33] * 64.f, q1, true);
            *(u32x2*)(WT8 + (size_t)(row - SPLIT8) * ldk + k0 + 8 * c) = (u32x2){(unsigned)q0, (unsigned)q1};
        } else if (row >= 0) *(u32x4*)(WT + (size_t)row * ldk + k0 + 8 * c) = o; }
    LDS_WAIT(); asm volatile("" ::: "memory");
}
struct RmId { __device__ __forceinline__ int operator()(int n) const { return n; } __device__ __forceinline__ float scale(int) const { return 1.f; } };
struct RmOff { int off; __device__ __forceinline__ int operator()(int n) const { return n + off; } __device__ __forceinline__ float scale(int) const { return 1.f; } };
struct RmGu { __device__ __forceinline__ int operator()(int n) const { if (n < FF) return 256 * (n >> 7) + (n & 127); const int j = n - FF; return 256 * (j >> 7) + 128 + (j & 127); }
    __device__ __forceinline__ float scale(int n) const { return n < FF ? LOG2E : 1.0f / LOG2E; } };
struct RmIn { __device__ __forceinline__ float scale(int) const { return 1.f; }
    __device__ __forceinline__ int operator()(int n) const {
    if (n < 1280) return n;
    if (n < 1536) return 2048 + (n - 1280);
    if (n < 1700) return 1792 + (n - 1536);
    if (n < 1956) return 1280 + (n - 1700);
    if (n < 2212) return 1536 + (n - 1956);
    const int g = n - 2212, nbr = g >> 10, j = g & 1023, pn = j >> 6, jj = j & 63;
    return 2304 + 256 * pn + 128 * (nbr >> 1) + 32 * (jj >> 4) + 16 * (nbr & 1) + (jj & 15);
} };

__device__ __forceinline__ void convert_layer(Frame& F, int l) {
    LAS float* scr = (LAS float*)(F.lds + F.wave * 16384);
    const int gw = F.bx * NWAVES + F.wave, lane = F.lane; constexpr int NGW = 256 * NWAVES;
    unsigned char* ws = F.ws;
    constexpr int I_GU = 16 * 176, I_D = 44 * 32, I_IN = 16 * 198, I_B = 4 * 4 * 32, I_O = 16 * 32;
    constexpr int NIT = 2 * I_GU + 2 * I_D + I_IN + I_B + I_O;
    for (int it = gw; it < NIT; it += NGW) {
        int r = it;
        if (r < I_GU) { cvt_item(F.in[3] + (size_t)l * DM * 2 * FF, 2 * FF, F.in[1] + l * DM, (bf16*)(ws + WS_WGU1), DM, scr, r / 176, r % 176, lane, RmGu()); continue; } r -= I_GU;
        if (r < I_GU) { cvt_item(F.in[21] + (size_t)l * DM * 2 * FF, 2 * FF, F.in[19] + l * DM, (bf16*)(ws + WS_WGU2), DM, scr, r / 176, r % 176, lane, RmGu()); continue; } r -= I_GU;
        if (r < I_D) { cvt_item(F.in[4] + (size_t)l * FF * DM, DM, nullptr, (bf16*)(ws + WS_WD1), FF, scr, r / 32, r % 32, lane, RmId()); continue; } r -= I_D;
        if (r < I_D) { cvt_item(F.in[22] + (size_t)l * FF * DM, DM, nullptr, (bf16*)(ws + WS_WD2), FF, scr, r / 32, r % 32, lane, RmId()); continue; } r -= I_D;
        if (r < I_IN) { cvt_item<RmIn, 2304>(F.in[7] + (size_t)l * DM * 6308, 6308, F.in[5] + l * DM, (bf16*)(ws + WS_WZ), DM, scr, r / 198, r % 198, lane, RmIn(), ws + WS_WG); continue; } r -= I_IN;
        if (r < I_B) { const int nbr = r / 128, rr = r % 128; cvt_item(F.in[17] + ((size_t)l * 4 + nbr) * 256 * DM, DM, nullptr, (bf16*)(ws + WS_WB), 256, scr, rr / 32, rr % 32, lane, RmOff{nbr * 1024}); continue; } r -= I_B;
        cvt_item(F.in[18] + (size_t)l * DM * DM, DM, nullptr, (bf16*)(ws + WS_WO), DM, scr, r / 32, r % 32, lane, RmId());
    }
    const int gt = F.bx * 512 + F.tid; constexpr int NGT = 256 * 512;
    { bf16* wz = (bf16*)(ws + WS_WZ); const int nel = (256 - 164) * 1024 / 8;
      for (int i = gt; i < nel; i += NGT) *(u32x4*)(wz + (size_t)(1792 + 164) * 1024 + (size_t)i * 8) = (u32x4){0u, 0u, 0u, 0u}; }
    { const float* src = F.in[9] + (size_t)l * 4 * 128 * 128; bf16* dst = (bf16*)(ws + WS_WSB);
      for (int i = gt; i < 4 * 128 * 128; i += NGT) { const int t = (i >> 7) & 127, s = i & 127; dst[i] = (bf16)f2bf(s <= t ? src[i] : 0.f); } }
    { const float* src = F.in[11] + (size_t)l * 4 * 64 * 64; bf16* dst = (bf16*)(ws + WS_PWT);
      for (int i = gt; i < 4 * 64 * 64; i += NGT) { const int g = i >> 12, dout = (i >> 6) & 63, cin = i & 63; dst[i] = (bf16)f2bf(src[(g * 64 + cin) * 64 + dout]); } }
}

__device__ __forceinline__ void norm_pass(Frame& F, const bf16* hb, const float* gpost, float alpha, bool init, bool last, bool w8 = false) {
    constexpr int NR = 4;
    const int gw = F.bx * NWAVES + F.wave, lane = F.lane; constexpr int NGW = 256 * NWAVES;
    bf16* xb = (bf16*)(F.ws + WS_XB); float* rstd = (float*)(F.ws + WS_RSTD);
    f32x4 g[2][2];
#pragma unroll
    for (int j = 0; j < 2; ++j)
#pragma unroll
        for (int k = 0; k < 2; ++k) g[j][k] = init ? (f32x4){0.f, 0.f, 0.f, 0.f} : *(const f32x4*)(gpost + 8 * lane + 512 * j + 4 * k);
    for (int row0 = gw * NR; row0 < M; row0 += NGW * NR) {
        f32x4 x[NR][2][2]; u32x4 hw[NR][2];
        if (init) {
#pragma unroll
            for (int r = 0; r < NR; ++r)
#pragma unroll
                for (int j = 0; j < 2; ++j) { const float* p = F.in[0] + (size_t)(row0 + r) * DM + 8 * lane + 512 * j; x[r][j][0] = *(const f32x4*)p; x[r][j][1] = *(const f32x4*)(p + 4); hw[r][j] = (u32x4){0u, 0u, 0u, 0u}; }
        } else {
            u32x4 xw[NR][2]; float inv[NR];
#pragma unroll
            for (int r = 0; r < NR; ++r) { inv[r] = rstd[row0 + r];
#pragma unroll
                for (int j = 0; j < 2; ++j) { const size_t off = (size_t)(row0 + r) * DM + 8 * lane + 512 * j; xw[r][j] = *(const u32x4*)(xb + off); hw[r][j] = *(const u32x4*)(hb + off); } }
#pragma unroll
            for (int r = 0; r < NR; ++r) { const float iv = 1.0f / inv[r];
#pragma unroll
                for (int j = 0; j < 2; ++j) { x[r][j][0] = (f32x4){bflo(xw[r][j].x), bfhi(xw[r][j].x), bflo(xw[r][j].y), bfhi(xw[r][j].y)} * iv; x[r][j][1] = (f32x4){bflo(xw[r][j].z), bfhi(xw[r][j].z), bflo(xw[r][j].w), bfhi(xw[r][j].w)} * iv; } }
        }
#pragma unroll
        for (int r = 0; r < NR; ++r) {
            const int row = row0 + r;
            if (!init) {
                f32x4 h[2][2]; float ss = 0.f;
#pragma unroll
                for (int j = 0; j < 2; ++j) { h[j][0] = (f32x4){bflo(hw[r][j].x), bfhi(hw[r][j].x), bflo(hw[r][j].y), bfhi(hw[r][j].y)}; h[j][1] = (f32x4){bflo(hw[r][j].z), bfhi(hw[r][j].z), bflo(hw[r][j].w), bfhi(hw[r][j].w)};
#pragma unroll
                    for (int k = 0; k < 2; ++k) ss += (h[j][k][0] * h[j][k][0] + h[j][k][1] * h[j][k][1]) + (h[j][k][2] * h[j][k][2] + h[j][k][3] * h[j][k][3]); }
                const float rr = alpha * __builtin_amdgcn_rsqf(wave_sum(ss) * (1.f / DM) + EPS);
#pragma unroll
                for (int j = 0; j < 2; ++j)
#pragma unroll
                    for (int k = 0; k < 2; ++k) x[r][j][k] = x[r][j][k] + h[j][k] * g[j][k] * rr;
            }
            float s2 = 0.f;
#pragma unroll
            for (int j = 0; j < 2; ++j)
#pragma unroll
                for (int k = 0; k < 2; ++k) { const f32x4 v = x[r][j][k]; s2 += (v[0] * v[0] + v[1] * v[1]) + (v[2] * v[2] + v[3] * v[3]); }
            const float rsn = __builtin_amdgcn_rsqf(wave_sum(s2) * (1.f / DM) + EPS);
#pragma unroll
            for (int j = 0; j < 2; ++j) { const size_t off = (size_t)row * DM + 8 * lane + 512 * j; const f32x4 v0 = x[r][j][0], v1 = x[r][j][1], n0 = v0 * rsn, n1 = v1 * rsn;
                u32x4 w; w.x = pk2(n0[0], n0[1]); w.y = pk2(n0[2], n0[3]); w.z = pk2(n1[0], n1[1]); w.w = pk2(n1[2], n1[3]); if (!last) *(u32x4*)(xb + off) = w;
                if (last) { *(f32x4*)(F.out + off) = v0; *(f32x4*)(F.out + off + 4) = v1; }
                if (w8) { int q0 = 0, q1 = 0; q0 = __builtin_amdgcn_cvt_pk_fp8_f32(n0[0], n0[1], q0, false); q0 = __builtin_amdgcn_cvt_pk_fp8_f32(n0[2], n0[3], q0, true);
                    q1 = __builtin_amdgcn_cvt_pk_fp8_f32(n1[0], n1[1], q1, false); q1 = __builtin_amdgcn_cvt_pk_fp8_f32(n1[2], n1[3], q1, true); *(u32x2*)((unsigned char*)F.out + off) = (u32x2){(unsigned)q0, (unsigned)q1}; } }
            if (lane == 0 && !last) rstd[row] = rsn;
        }
    }
}

__device__ __forceinline__ f32x4 mfma16(bf16x8 a, bf16x8 b, f32x4 c) { return __builtin_amdgcn_mfma_f32_16x16x32_bf16(a, b, c, 0, 0, 0); }
__device__ __forceinline__ void mixers_unit(Frame& F, int l_in, int chunk) {
    const int w = F.wave;
    const int r0 = chunk * 128, b = chunk >> 6, t0 = (chunk & 63) * 128;
    const bf16* Z = (const bf16*)(F.ws + WS_AR + AR_Z); bf16* BR = (bf16*)(F.ws + WS_BR);
    LAS unsigned char* lds = F.lds;
    {
        int l = l_in, tid = F.tid, lane; asm volatile("" : "+s"(l), "+v"(tid)); lane = tid & 63; const int fr = lane & 15, fq = lane >> 4;
        constexpr int VS = 136;
        LAS bf16* vnT = (LAS bf16*)lds;
        const float* vg = F.in[8] + l * 256;
        const f32x4 g4 = *(const f32x4*)(vg + 4 * lane);
        u32x2 wv[16];
#pragma unroll
        for (int i = 0; i < 16; ++i) wv[i] = *(const u32x2*)(Z + (size_t)(r0 + w * 16 + i) * ZW + ZV + 4 * lane);
#pragma unroll
        for (int i = 0; i < 16; ++i) { const int s = w * 16 + i;
            const float v0 = bflo(wv[i].x), v1 = bfhi(wv[i].x), v2 = bflo(wv[i].y), v3 = bfhi(wv[i].y);
            const float rs = __builtin_amdgcn_rsqf(wave_sum((v0 * v0 + v1 * v1) + (v2 * v2 + v3 * v3)) * (1.f / 256) + EPS);
            const unsigned p01 = pk2(v0 * rs * g4[0], v1 * rs * g4[1]), p23 = pk2(v2 * rs * g4[2], v3 * rs * g4[3]);
            vnT[(4 * lane + 0) * VS + s] = (bf16)(p01 & 0xffffu); vnT[(4 * lane + 1) * VS + s] = (bf16)(p01 >> 16);
            vnT[(4 * lane + 2) * VS + s] = (bf16)(p23 & 0xffffu); vnT[(4 * lane + 3) * VS + s] = (bf16)(p23 >> 16); }
        __syncthreads();
        const bf16* wsb = (const bf16*)(F.ws + WS_WSB); const float* gmb = F.in[10] + l * 512;
        const int tt = w, t = 16 * tt + fr;
        const int nkk = (16 * tt + 15) / 32 + 1;
        bf16x8 bfr[4][4]; float wbv[4]; u32x2 uw[4][4];
#pragma unroll
        for (int g = 0; g < 4; ++g) { wbv[g] = gmb[g * 128 + t];
#pragma unroll
            for (int kk = 0; kk < 4; ++kk) bfr[g][kk] = (kk < nkk) ? *(const bf16x8*)(wsb + ((size_t)(g * 128 + t)) * 128 + 32 * kk + 8 * fq) : (bf16x8){0, 0, 0, 0, 0, 0, 0, 0};
#pragma unroll
            for (int ct = 0; ct < 4; ++ct) uw[g][ct] = *(const u32x2*)(Z + (size_t)(r0 + t) * ZW + ZU + 64 * g + 16 * ct + 4 * fq); }
#pragma unroll
        for (int g = 0; g < 4; ++g) {
#pragma unroll
            for (int ct = 0; ct < 4; ++ct) {
                f32x4 acc = (f32x4){0.f, 0.f, 0.f, 0.f};
#pragma unroll
                for (int kk = 0; kk < 4; ++kk) if (kk < nkk) { const bf16x8 a = *(const LAS bf16x8*)(vnT + (64 * g + 16 * ct + fr) * VS + 32 * kk + 8 * fq); acc = mfma16(a, bfr[g][kk], acc); }
                const int c = 64 * g + 16 * ct + 4 * fq; const float wb = wbv[g]; const u32x2 u2 = uw[g][ct];
                u32x2 o; o.x = pk2(bflo(u2.x) * (acc[0] + wb), bfhi(u2.x) * (acc[1] + wb)); o.y = pk2(bflo(u2.y) * (acc[2] + wb), bfhi(u2.y) * (acc[3] + wb));
                *(u32x2*)(BR + (size_t)(r0 + t) * 1024 + c) = o; }
        }
        __syncthreads();
    }
    {
        int l = l_in, tid = F.tid, lane; asm volatile("" : "+s"(l), "+v"(tid)); lane = tid & 63; const int fr = lane & 15, fq = lane >> 4;
        constexpr int DS = 264;
        LAS bf16* pL = (LAS bf16*)lds;
        LAS bf16* dL = (LAS bf16*)(lds + 144 * 512);
        { u32x4 pv[9];
#pragma unroll
          for (int k = 0; k < 9; ++k) { const int it = tid + 512 * k; const int ri = it >> 5, c8 = (it & 31) * 8; const int tp = t0 - 16 + ri;
              pv[k] = (tp >= 0) ? *(const u32x4*)(Z + (size_t)(b * SEQ + tp) * ZW + ZP + c8) : (u32x4){0u, 0u, 0u, 0u}; }
#pragma unroll
          for (int k = 0; k < 9; ++k) { const int it = tid + 512 * k; *(LAS u32x4*)(pL + (size_t)it * 8) = pv[k]; } }
        __syncthreads();
        { const int c = tid & 255, th = tid >> 8, g = c >> 6, wdw = 2 << g;
          const int rs0 = 64 * th + 16; float sum = 0.f;
          for (int i = 1; i < wdw; ++i) sum += bf2f(pL[(rs0 - i) * 256 + c]);
#pragma unroll 8
          for (int i = 0; i < 64; ++i) { const int tp = t0 + 64 * th + i; const float p = bf2f(pL[(rs0 + i) * 256 + c]); sum += p;
              const int cntw = (tp + 1 < wdw) ? tp + 1 : wdw; const float d = sum * fast_rcp((float)cntw) - p;
              dL[(64 * th + i) * DS + c] = (bf16)f2bf(d);
              sum -= bf2f(pL[(rs0 + i - wdw + 1) * 256 + c]); } }
        __syncthreads();
        const bf16* pwT = (const bf16*)(F.ws + WS_PWT); const float* psc = F.in[12] + l * 256;
        const int tt = w, t = 16 * tt + fr;
#pragma unroll
        for (int g = 0; g < 4; ++g) {
            bf16x8 bfr[2];
#pragma unroll
            for (int kk = 0; kk < 2; ++kk) bfr[kk] = *(const LAS bf16x8*)(dL + t * DS + 64 * g + 32 * kk + 8 * fq);
#pragma unroll
            for (int dt = 0; dt < 4; ++dt) {
                f32x4 acc = (f32x4){0.f, 0.f, 0.f, 0.f};
#pragma unroll
                for (int kk = 0; kk < 2; ++kk) { const bf16x8 a = *(const bf16x8*)(pwT + (size_t)(g * 64 + 16 * dt + fr) * 64 + 32 * kk + 8 * fq); acc = mfma16(a, bfr[kk], acc); }
                const int c = 64 * g + 16 * dt + 4 * fq; const f32x4 sc = *(const f32x4*)(psc + c);
                u32x2 o; o.x = pk2(acc[0] * sc[0], acc[1] * sc[1]); o.y = pk2(acc[2] * sc[2], acc[3] * sc[3]);
                *(u32x2*)(BR + (size_t)(r0 + t) * 1024 + 256 + c) = o; }
        }
        __syncthreads();
    }
    {
        int l = l_in, tid = F.tid, lane; asm volatile("" : "+s"(l), "+v"(tid)); lane = tid & 63;
        LAS bf16* hg = (LAS bf16*)lds;
        LAS float* co = (LAS float*)(lds + 94 * 512);
        const int c = tid & 255, tq = tid >> 8;
        float wgt[31];
#pragma unroll
        for (int j = 0; j < 31; ++j) wgt[j] = F.in[13][((size_t)l * 31 + j) * 256 + c];
        const float cb = F.in[14][l * 256 + c];
        const f32x4 lg = *(const f32x4*)(F.in[15] + l * 256 + 4 * lane), lb = *(const f32x4*)(F.in[16] + l * 256 + 4 * lane);
        for (int hh = 0; hh < 2; ++hh) {
            const int tl0 = 64 * hh;
#pragma unroll
            for (int half = 0; half < 2; ++half) {
                u32x2 av[6], gv[6];
#pragma unroll
                for (int k = 0; k < 6; ++k) { const int it = tid + 512 * (6 * half + k); const int ri = it >> 6, c4 = (it & 63) * 4; const int tp = t0 + tl0 - 30 + ri;
                    const bool ok = (it < 94 * 64) && (tp >= 0); const bf16* zr = Z + (size_t)(b * SEQ + (ok ? tp : 0)) * ZW;
                    av[k] = ok ? *(const u32x2*)(zr + ZA + c4) : (u32x2){0u, 0u}; gv[k] = ok ? *(const u32x2*)(zr + ZG + c4) : (u32x2){0u, 0u}; }
#pragma unroll
                for (int k = 0; k < 6; ++k) { const int it = tid + 512 * (6 * half + k); const int ri = it >> 6, c4 = (it & 63) * 4;
                    u32x2 o; o.x = pk2(bflo(av[k].x) * sigmoidf_(bflo(gv[k].x)), bfhi(av[k].x) * sigmoidf_(bfhi(gv[k].x))); o.y = pk2(bflo(av[k].y) * sigmoidf_(bflo(gv[k].y)), bfhi(av[k].y) * sigmoidf_(bfhi(gv[k].y)));
                    if (it < 94 * 64) *(LAS u32x2*)(hg + ri * 256 + c4) = o; }
            }
            __syncthreads();
#pragma unroll 1
            for (int blk = 0; blk < 4; ++blk) {
                const int tb = 32 * tq + 8 * blk; float inp[38];
#pragma unroll
                for (int i = 0; i < 38; ++i) inp[i] = bf2f(hg[(tb + i) * 256 + c]);
#pragma unroll
                for (int o = 0; o < 8; ++o) { float a = cb;
#pragma unroll
                    for (int j = 0; j < 31; ++j) a += wgt[j] * inp[o + j];
                    co[(tb + o) * 256 + c] = a; }
            }
            __syncthreads();
#pragma unroll
            for (int i = 0; i < 8; ++i) { const int tl = w * 8 + i; const f32x4 v = *(const LAS f32x4*)(co + tl * 256 + 4 * lane);
                const float mu = wave_sum((v[0] + v[1]) + (v[2] + v[3])) * (1.f / 256); const f32x4 d = v - mu;
                const float rs = __builtin_amdgcn_rsqf(wave_sum((d[0] * d[0] + d[1] * d[1]) + (d[2] * d[2] + d[3] * d[3])) * (1.f / 256) + EPS);
                const f32x4 y = d * rs * lg + lb;
                u32x2 o; o.x = pk2(siluf_(y[0]), siluf_(y[1])); o.y = pk2(siluf_(y[2]), siluf_(y[3]));
                *(u32x2*)(BR + (size_t)(r0 + tl0 + tl) * 1024 + 768 + 4 * lane) = o; }
            __syncthreads();
        }
    }
}

constexpr int HS = 1028;
constexpr int MSW = 257;
constexpr unsigned R_ALL = 0x7fffffffu;
__device__ __forceinline__ unsigned okey(float s) { const unsigned u = __builtin_bit_cast(unsigned, s); return u ^ ((unsigned)((int)u >> 31) | 0x80000000u); }
template <int CTRL, int RM> __device__ __forceinline__ unsigned dpp_shift(unsigned v) { return (unsigned)__builtin_amdgcn_update_dpp(0, (int)v, CTRL, RM, 0xf, false); }
__device__ __forceinline__ unsigned wave_incl_scan(unsigned v) {
    v += dpp_shift<0x111, 0xf>(v); v += dpp_shift<0x112, 0xf>(v); v += dpp_shift<0x114, 0xf>(v); v += dpp_shift<0x118, 0xf>(v);
    v += dpp_shift<0x142, 0xa>(v);
    v += dpp_shift<0x143, 0xc>(v);
    return v;
}
__device__ __forceinline__ void find_bin4(const LAS unsigned* h0, const unsigned (&Kneed)[4], int lane, unsigned (&bin_out)[4], unsigned (&need_out)[4], unsigned (&cnt_out)[4]) {
    unsigned cnt[4][16]; unsigned s[4], incl[4];
#pragma unroll
    for (int r = 0; r < 4; ++r) { s[r] = 0;
#pragma unroll
        for (int q4 = 0; q4 < 4; ++q4) { const u32x4 v = *(const LAS u32x4*)(h0 + r * HS + 1008 - 16 * lane + 4 * (3 - q4));
            cnt[r][4 * q4 + 0] = v.w; cnt[r][4 * q4 + 1] = v.z; cnt[r][4 * q4 + 2] = v.y; cnt[r][4 * q4 + 3] = v.x; s[r] += (v.x + v.y) + (v.z + v.w); }
        incl[r] = s[r]; }
#pragma unroll
    for (int r = 0; r < 4; ++r) incl[r] = wave_incl_scan(incl[r]);
#pragma unroll
    for (int r = 0; r < 4; ++r) {
        const unsigned excl = incl[r] - s[r];
        unsigned bin = 0, need = 0, cn = 0; const bool mine = (excl < Kneed[r]) && (incl[r] >= Kneed[r]);
        if (mine) { unsigned c = excl; bool done = false;
#pragma unroll
            for (int q = 0; q < 16; ++q) { if (!done) { const unsigned c2 = c + cnt[r][q]; if (c2 >= Kneed[r]) { bin = 1023 - 16 * lane - q; need = Kneed[r] - c; cn = cnt[r][q]; done = true; } c = c2; } } }
        const unsigned long long bal = __ballot(mine); const int src = bal ? (int)__builtin_ctzll(bal) : 0;
        bin_out[r] = (unsigned)__builtin_amdgcn_readlane((int)bin, src); need_out[r] = (unsigned)__builtin_amdgcn_readlane((int)need, src); cnt_out[r] = (unsigned)__builtin_amdgcn_readlane((int)cn, src);
    }
}
typedef float f32x2 __attribute__((ext_vector_type(2)));
__device__ __forceinline__ f32x2 relu_pk(f32x2 d, f32x2 sc) { f32x2 r; asm("v_pk_mul_f32 %0, %1, %2 clamp" : "=v"(r) : "v"(d), "v"(sc)); return r; }
template <int PASS, bool CHECK>
__device__ __forceinline__ void select_tile(const bf16x8 kcur, const bf16x8 (&qf)[2][4], const f32x2 (&av)[2][4], const f32x2 sc2, int kt, int fr, int fq, int t0,
                                            LAS unsigned* hist, const unsigned (&base1)[2], const unsigned (&mytau)[2], const bool (&flagged)[2], bool anyflag) {
    const f32x4 zero4 = (f32x4){0.f, 0.f, 0.f, 0.f};
    const int kbase = 16 * kt + 4 * fq;
    f32x4 dall[2][4];
#pragma unroll
    for (int rg = 0; rg < 2; ++rg)
#pragma unroll
        for (int h = 0; h < 4; ++h) dall[rg][h] = mfma16(kcur, qf[rg][h], zero4);
    asm volatile("s_nop 15" : "+v"(dall[0][0]), "+v"(dall[0][1]), "+v"(dall[0][2]), "+v"(dall[0][3]), "+v"(dall[1][0]), "+v"(dall[1][1]), "+v"(dall[1][2]), "+v"(dall[1][3]));
#pragma unroll
    for (int rg = 0; rg < 2; ++rg) {
        const int rl = 16 * rg + fr, t = t0 + rl;
        f32x2 s01 = (f32x2){96.f, 96.f}, s23 = (f32x2){96.f, 96.f};
#pragma unroll
        for (int h = 0; h < 4; ++h) { const f32x4 d = dall[rg][h];
            const f32x2 r01 = relu_pk((f32x2){d[0], d[1]}, sc2), r23 = relu_pk((f32x2){d[2], d[3]}, sc2);
            s01 = __builtin_elementwise_fma(av[rg][h], r01, s01); s23 = __builtin_elementwise_fma(av[rg][h], r23, s23); }
        const float sv0 = s01[0], sv1 = s01[1], sv2 = s23[0], sv3 = s23[1];
        unsigned bits[4] = {__builtin_bit_cast(unsigned, sv0), __builtin_bit_cast(unsigned, sv1), __builtin_bit_cast(unsigned, sv2), __builtin_bit_cast(unsigned, sv3)};
        if (PASS == 0) {
            const unsigned rowb = (unsigned)(size_t)(hist + rl * HS);
#pragma unroll
            for (int i = 0; i < 4; ++i) { unsigned addr;
                asm("v_bfe_u32 %0, %1, 13, 10\n\tv_lshl_add_u32 %0, %0, 2, %2" : "=&v"(addr) : "v"(bits[i]), "v"(rowb));
                if (!CHECK || kbase + i <= t) __hip_atomic_fetch_add((LAS unsigned*)(size_t)addr, 1u, __ATOMIC_RELAXED, __HIP_MEMORY_SCOPE_WORKGROUP); }
        } else if (PASS == 1) {
#pragma unroll
            for (int i = 0; i < 4; ++i) { const unsigned k20 = __builtin_amdgcn_ubfe(bits[i], 3, 20); unsigned idx = k20 - base1[rg]; idx = idx < 1024u ? idx : 1024u;
                if (CHECK && kbase + i > t) idx = 1024u;
                __hip_atomic_fetch_add(hist + rl * HS + idx, 1u, __ATOMIC_RELAXED, __HIP_MEMORY_SCOPE_WORKGROUP); }
        } else {
            LAS unsigned* sel = hist; LAS unsigned* eqm = hist + 32 * MSW;
            const unsigned taub = 0x42800000u | (mytau[rg] << 3);
            unsigned nib = 0;
#pragma unroll
            for (int i = 3; i >= 0; --i) { const unsigned bb = (!CHECK || kbase + i <= t) ? bits[i] : 0u;
                asm("v_cmp_ge_u32 vcc, %1, %2\n\tv_addc_co_u32 %0, vcc, %0, %0, vcc" : "+v"(nib) : "v"(bb), "v"(taub) : "vcc"); }
            const int sh = 16 * (kt & 1) + 4 * fq;
            __hip_atomic_fetch_or(sel + rl * MSW + (kt >> 1), nib << sh, __ATOMIC_RELAXED, __HIP_MEMORY_SCOPE_WORKGROUP);
            if (anyflag) {
                const unsigned taub8 = taub + 8u; unsigned nlt = 0;
#pragma unroll
                for (int i = 3; i >= 0; --i) asm("v_cmp_lt_u32 vcc, %1, %2\n\tv_addc_co_u32 %0, vcc, %0, %0, vcc" : "+v"(nlt) : "v"(bits[i]), "v"(taub8) : "vcc");
                const unsigned nibe = flagged[rg] ? (nib & nlt) : 0u;
                if (nibe) __hip_atomic_fetch_or(eqm + rl * MSW + (kt >> 1), nibe << sh, __ATOMIC_RELAXED, __HIP_MEMORY_SCOPE_WORKGROUP); }
        }
    }
}
template <int PASS>
__device__ __forceinline__ void select_pass(const bf16* KI, const bf16x8 (&qf)[2][4], const f32x2 (&av)[2][4], int nkt, int j, int w, int fr, int fq, int t0,
                                            LAS unsigned* hist, const unsigned (&base1)[2], const unsigned (&mytau)[2], const bool (&flagged)[2], bool anyflag) {
#define KLOAD(kt) (*(const bf16x8*)((KI + (size_t)(kt) * 512) + kloff))
    const unsigned kloff = (unsigned)(fr * 32 + 8 * fq);
    const f32x2 sc2 = (f32x2){0.0078125f, 0.0078125f};
    const int nfull = 2 * j;
    bf16x8 kq[4];
#pragma unroll
    for (int u = 0; u < 4; ++u) { const int kl = w + 8 * u; kq[u] = KLOAD(kl < nkt ? kl : nkt - 1); }
    for (int kt0 = w; kt0 < nkt; kt0 += 32) {
#pragma unroll
        for (int u = 0; u < 4; ++u) {
            const int kt = kt0 + 8 * u;
            const bf16x8 kcur = kq[u];
            { const int kl = kt + 32; kq[u] = KLOAD(kl < nkt ? kl : nkt - 1); }
            if (kt < nfull) select_tile<PASS, false>(kcur, qf, av, sc2, kt, fr, fq, t0, hist, base1, mytau, flagged, anyflag);
            else select_tile<PASS, true>(kcur, qf, av, sc2, kt, fr, fq, t0, hist, base1, mytau, flagged, anyflag);
        }
    }
#undef KLOAD
}
__device__ __forceinline__ void select_unit(Frame& F, int b, int j) {
    const int tid = F.tid, lane = F.lane, w = F.wave, fr = lane & 15, fq = lane >> 4;
    const int t0 = 32 * j;
    unsigned char* ar = F.ws + WS_AR;
    const bf16* QI = (const bf16*)(ar + AR_QI); const bf16* KI = (const bf16*)(ar + AR_KI) + (size_t)b * SEQ * 32; const float* WI = (const float*)(ar + AR_WI);
    unsigned long long* M8 = (unsigned long long*)(ar + AR_M8);
    LAS unsigned* hist = (LAS unsigned*)F.lds;
    LAS unsigned* info = (LAS unsigned*)(F.lds + 32 * HS * 4);
    bf16x8 qf[2][4]; f32x2 av[2][4];
#pragma unroll
    for (int rg = 0; rg < 2; ++rg) { const size_t grow = (size_t)b * SEQ + t0 + 16 * rg + fr;
#pragma unroll
        for (int h = 0; h < 4; ++h) qf[rg][h] = *(const bf16x8*)(QI + grow * 128 + 32 * h + 8 * fq);
        const f32x4 w4 = *(const f32x4*)(WI + grow * 4); const float sa = __builtin_fabsf(w4[0]) + __builtin_fabsf(w4[1]) + __builtin_fabsf(w4[2]) + __builtin_fabsf(w4[3]);
        const float nrm = sa > 0.f ? 31.0f / sa : 0.f;
#pragma unroll
        for (int h = 0; h < 4; ++h) { const float a = w4[h] * nrm; av[rg][h] = (f32x2){a, a}; } }
    const int nkt = 2 * j + 2;
    LAS unsigned* sel = hist; LAS unsigned* eqm = hist + 32 * MSW;
    { const f32x2 tv = relu_pk((f32x2){(float)lane - 1.5f, 300.f - (float)lane}, (f32x2){0.0078125f, 0.0078125f});
      const float e0 = __builtin_fminf(__builtin_fmaxf(((float)lane - 1.5f) * 0.0078125f, 0.f), 1.f), e1 = __builtin_fminf(__builtin_fmaxf((300.f - (float)lane) * 0.0078125f, 0.f), 1.f);
      if (tv.x != e0 || tv.y != e1) ((float*)(F.ws + WS_RSTD))[0] = __builtin_nanf(""); }
    unsigned base1[2] = {0u, 0u}, mytau[2] = {0u, 0u}; bool flagged[2] = {false, false};
    for (int i = tid; i < 32 * HS / 4; i += 512) ((LAS u32x4*)hist)[i] = (u32x4){0u, 0u, 0u, 0u};
    __syncthreads();
    select_pass<0>(KI, qf, av, nkt, j, w, fr, fq, t0, hist, base1, mytau, flagged, false);
    __syncthreads();
    { const unsigned kn[4] = {256u, 256u, 256u, 256u}; unsigned bin[4], need[4], cn[4];
      if (t0 + 32 > 256) find_bin4(hist + 4 * w * HS, kn, lane, bin, need, cn);
#pragma unroll
      for (int rr = 0; rr < 4; ++rr) { const int row = 4 * w + rr; const int n = t0 + row + 1;
          if (lane == 0) { if (n <= 256) { info[row] = 0x100000u; info[32 + row] = 0u; } else { info[row] = bin[rr] << 10; info[32 + row] = need[rr]; } } } }
    __syncthreads();
    base1[0] = info[fr]; base1[1] = info[16 + fr];
    __syncthreads();
    for (int i = tid; i < 32 * HS / 4; i += 512) ((LAS u32x4*)hist)[i] = (u32x4){0u, 0u, 0u, 0u};
    __syncthreads();
    select_pass<1>(KI, qf, av, nkt, j, w, fr, fq, t0, hist, base1, mytau, flagged, false);
    __syncthreads();
    { unsigned kn[4], bin[4], need[4], cn[4];
#pragma unroll
      for (int rr = 0; rr < 4; ++rr) { kn[rr] = info[32 + 4 * w + rr]; if (kn[rr] == 0u) kn[rr] = 1u; }
      if (t0 + 32 > 256) find_bin4(hist + 4 * w * HS, kn, lane, bin, need, cn);
#pragma unroll
      for (int rr = 0; rr < 4; ++rr) { const int row = 4 * w + rr; const int n = t0 + row + 1;
          if (lane == 0) { if (n <= 256) { info[64 + row] = 0u; info[96 + row] = R_ALL; } else { info[64 + row] = info[row] | bin[rr]; info[96 + row] = (need[rr] == cn[rr]) ? R_ALL : need[rr]; } } } }
    __syncthreads();
    mytau[0] = info[64 + fr]; mytau[1] = info[64 + 16 + fr]; flagged[0] = info[96 + fr] != R_ALL; flagged[1] = info[96 + 16 + fr] != R_ALL;
    const bool anyflag = __any(flagged[0] || flagged[1]);
    __syncthreads();
    for (int i = tid; i < 2 * 32 * MSW / 4; i += 512) ((LAS u32x4*)hist)[i] = (u32x4){0u, 0u, 0u, 0u};
    __syncthreads();
    select_pass<2>(KI, qf, av, nkt, j, w, fr, fq, t0, hist, base1, mytau, flagged, anyflag);
    __syncthreads();
    for (int rr = 0; rr < 4; ++rr) { const int row = 4 * w + rr; const unsigned r = info[96 + row];
        if (r != R_ALL) {
            unsigned ew[4]; unsigned s = 0;
#pragma unroll
            for (int q = 0; q < 4; ++q) { ew[q] = eqm[row * MSW + 4 * lane + q]; s += __builtin_popcount(ew[q]); }
            unsigned incl = s;
            incl = wave_incl_scan(incl);
            unsigned cb = incl - s;
#pragma unroll
            for (int q = 0; q < 4; ++q) { const unsigned ww = ew[q]; const int pc = __builtin_popcount(ww); const int allow = (int)r - (int)cb; unsigned kill;
                if (allow <= 0) kill = ww; else if (allow >= pc) kill = 0u; else { unsigned tmp = ww, kept = 0u; for (int a = 0; a < allow; ++a) { const unsigned low = tmp & (0u - tmp); kept |= low; tmp ^= low; } kill = ww & ~kept; }
                if (kill) sel[row * MSW + 4 * lane + q] &= ~kill; cb += pc; }
        } }
    __syncthreads();
    const int ntw = 4 * (j >> 3) + 4;
    for (int idx = tid; idx < ntw * 32; idx += 512) { const int T = idx >> 5, r2 = idx & 31;
        const unsigned lo = sel[r2 * MSW + 2 * T], hi = sel[r2 * MSW + 2 * T + 1];
        M8[((size_t)(b * 128 + T)) * SEQ + t0 + r2] = (unsigned long long)lo | ((unsigned long long)hi << 32); }
    __syncthreads();
}

__device__ __forceinline__ int crow(int r, int hi) { return (r & 3) + 8 * (r >> 2) + 4 * hi; }
__device__ __forceinline__ f32x16 mfma32(bf16x8 a, bf16x8 b, f32x16 c) { return __builtin_amdgcn_mfma_f32_32x32x16_bf16(a, b, c, 0, 0, 0); }
__device__ __forceinline__ void attn_unit(Frame& F, int b, int h, int qb) {
    constexpr int KST = 144;
    const int tid = F.tid, lane = F.lane, w = F.wave, r32 = lane & 31, hi = lane >> 5;
    unsigned char* ar = F.ws + WS_AR;
    const bf16* Z = (const bf16*)(ar + AR_Z); const bf16* VT = (const bf16*)(ar + AR_VT); const unsigned long long* M8 = (const unsigned long long*)(ar + AR_M8);
    bf16* BR = (bf16*)(F.ws + WS_BR);
    LAS unsigned char* Kb = F.lds; LAS unsigned char* Vb = F.lds + 2 * 64 * KST; LAS float* lut = (LAS float*)(F.lds + 4 * 64 * KST);
    const int q0 = 256 * qb, NT = 4 * qb + 4, q = q0 + 32 * w + r32;
    const size_t grow = (size_t)b * SEQ + q;
    if (tid < 384) { float v = 0.f; const int n = 256 - tid;
        if (n >= 0 && n < 128) { int bk = n;
            if (n >= 16) { bk = 16; const int thr[15] = {19, 21, 24, 27, 31, 35, 40, 46, 52, 59, 67, 77, 87, 99, 113};
#pragma unroll
                for (int i = 0; i < 15; ++i) bk += (n >= thr[i]) ? 1 : 0; }
            v = (F.in[23][bk * 4 + h] - F.in[23][31 * 4 + h]) * LOG2E; }
        lut[tid] = v; }
    bf16x8 qf[4];
#pragma unroll
    for (int d0 = 0; d0 < 4; ++d0) qf[d0] = *(const bf16x8*)(Z + grow * ZW + ZQ + 64 * h + 16 * d0 + 8 * hi);
    const int sr = tid >> 3, ch = tid & 7;
    const bf16* kg = (const bf16*)(ar + AR_KC) + ((size_t)(b * 4 + h) * SEQ + sr) * 64 + 8 * ch;
    const bf16* vg = VT + ((size_t)(b * 4 + h) * 128 * 64 + sr) * 64 + 8 * ch;
    const int sdst = sr * KST + 16 * ch;
    const unsigned long long* mp = M8 + (size_t)b * 128 * SEQ + q;
    { const u32x4 k4 = *(const u32x4*)kg, v4 = *(const u32x4*)vg; *(LAS u32x4*)(Kb + sdst) = k4; *(LAS u32x4*)(Vb + sdst) = v4; }
    __syncthreads();
    f32x16 o0 = {}, o1 = {}; f32x16 negm = {}; float mref = 0.f, lsumv = 0.f;
    unsigned long long mk = mp[0];
    u32x4 kA = *(const u32x4*)(kg + (size_t)1 * 4096), vA = *(const u32x4*)(vg + (size_t)1 * 4096); unsigned long long mA = mp[(size_t)1 * SEQ];
    u32x4 kB = *(const u32x4*)(kg + (size_t)2 * 4096), vB = *(const u32x4*)(vg + (size_t)2 * 4096); unsigned long long mB = mp[(size_t)2 * SEQ];
#define ATT_MATHS(T, buf) do { \
        const LAS unsigned char* Kc = Kb + buf * 64 * KST; const LAS unsigned char* Vc = Vb + buf * 64 * KST; \
        if (64 * T <= q0 + 32 * w + 31) { \
        f32x16 p0 = negm, p1 = negm; \
        { bf16x8 kf[8]; \
        _Pragma("unroll") \
          for (int d0 = 0; d0 < 4; ++d0) { kf[2 * d0] = *(const LAS bf16x8*)(Kc + r32 * KST + 32 * d0 + 16 * hi); kf[2 * d0 + 1] = *(const LAS bf16x8*)(Kc + (32 + r32) * KST + 32 * d0 + 16 * hi); } \
          __builtin_amdgcn_sched_barrier(0); \
        _Pragma("unroll") \
          for (int d0 = 0; d0 < 4; ++d0) { p0 = mfma32(kf[2 * d0], qf[d0], p0); p1 = mfma32(kf[2 * d0 + 1], qf[d0], p1); } \
          __builtin_amdgcn_sched_barrier(0); } \
        u32x4 vf[8];     \
        _Pragma("unroll") \
        for (int ks = 0; ks < 4; ++ks) { \
            vf[2 * ks] = *(const LAS u32x4*)(Vc + r32 * KST + 32 * ks + 16 * hi); \
            vf[2 * ks + 1] = *(const LAS u32x4*)(Vc + (32 + r32) * KST + 32 * ks + 16 * hi); } \
        __builtin_amdgcn_sched_barrier(0); \
        if (64 * T + 63 + 128 > q0 + 32 * w) { \
        _Pragma("unroll") \
            for (int r = 0; r < 16; ++r) { const LAS float* lb_ = lut + (256 - q + 64 * T + 4 * hi); const int o_ = (r & 3) + 8 * (r >> 2); \
                p0[r] += lb_[o_]; p1[r] += lb_[o_ + 32]; } \
        } \
        float rm = p0[0]; \
        _Pragma("unroll") \
        for (int r = 1; r < 16; ++r) rm = __builtin_fmaxf(rm, p0[r]); \
        _Pragma("unroll") \
        for (int r = 0; r < 16; ++r) rm = __builtin_fmaxf(rm, p1[r]); \
        { const auto rr_ = __builtin_amdgcn_permlane32_swap(__builtin_bit_cast(unsigned, rm), __builtin_bit_cast(unsigned, rm), false, false); rm = __builtin_fmaxf(__builtin_bit_cast(float, rr_[0]), __builtin_bit_cast(float, rr_[1])); } \
        if (T == 0 || __any(rm > 8.f)) { \
            const float dl = (T == 0) ? rm : __builtin_fmaxf(rm, 0.f); mref += dl; \
            const float f = fast_exp2(-dl); lsumv *= f; \
        _Pragma("unroll") \
            for (int r = 0; r < 16; ++r) { p0[r] -= dl; p1[r] -= dl; o0[r] *= f; o1[r] *= f; negm[r] = -mref; } \
        } \
        const unsigned mlo = (unsigned)mk >> (4 * hi), mhi = (unsigned)(mk >> 32) >> (4 * hi); \
        _Pragma("unroll") \
        for (int r = 0; r < 16; ++r) { const int pos = (r & 3) + 8 * (r >> 2); \
            unsigned m0 = (unsigned)__builtin_amdgcn_sbfe((int)mlo, pos, 1), m1 = (unsigned)__builtin_amdgcn_sbfe((int)mhi, pos, 1); \
            asm("" : "+v"(m0), "+v"(m1)); \
            p0[r] = __builtin_bit_cast(float, __builtin_bit_cast(unsigned, fast_exp2(p0[r])) & m0); \
            p1[r] = __builtin_bit_cast(float, __builtin_bit_cast(unsigned, fast_exp2(p1[r])) & m1); lsumv += p0[r] + p1[r]; } \
        bf16x8 pw[4]; \
        { u32x4 a; a.x = pk2(p0[0], p0[1]); a.y = pk2(p0[2], p0[3]); a.z = pk2(p0[4], p0[5]); a.w = pk2(p0[6], p0[7]); pw[0] = __builtin_bit_cast(bf16x8, a); \
          a.x = pk2(p0[8], p0[9]); a.y = pk2(p0[10], p0[11]); a.z = pk2(p0[12], p0[13]); a.w = pk2(p0[14], p0[15]); pw[1] = __builtin_bit_cast(bf16x8, a); \
          a.x = pk2(p1[0], p1[1]); a.y = pk2(p1[2], p1[3]); a.z = pk2(p1[4], p1[5]); a.w = pk2(p1[6], p1[7]); pw[2] = __builtin_bit_cast(bf16x8, a); \
          a.x = pk2(p1[8], p1[9]); a.y = pk2(p1[10], p1[11]); a.z = pk2(p1[12], p1[13]); a.w = pk2(p1[14], p1[15]); pw[3] = __builtin_bit_cast(bf16x8, a); } \
        { __builtin_amdgcn_sched_barrier(0); \
        _Pragma("unroll") \
          for (int ks = 0; ks < 4; ++ks) { o0 = mfma32(__builtin_bit_cast(bf16x8, vf[2 * ks]), pw[ks], o0); o1 = mfma32(__builtin_bit_cast(bf16x8, vf[2 * ks + 1]), pw[ks], o1); } \
          __builtin_amdgcn_sched_barrier(0); } \
        } \
    } while (0)
#define ATT_STEP(T, KS, VS, MS) do { const int T_ = (T); const int buf_ = T_ & 1; \
          \
        if ((T) + 1 < NT) { *(LAS u32x4*)(Kb + (buf_ ^ 1) * 64 * KST + sdst) = KS; *(LAS u32x4*)(Vb + (buf_ ^ 1) * 64 * KST + sdst) = VS; } \
        const unsigned long long mnext_ = MS; \
        { const int tn_ = ((T) + 3 < NT) ? (T) + 3 : NT - 1; KS = *(const u32x4*)(kg + (size_t)tn_ * 4096); VS = *(const u32x4*)(vg + (size_t)tn_ * 4096); MS = mp[(size_t)tn_ * SEQ]; } \
        ATT_MATHS(T_, buf_); \
        mk = mnext_; \
        asm volatile("s_waitcnt lgkmcnt(0)\n\ts_barrier" ::: "memory"); } while (0)
    for (int T = 0; T < NT; T += 2) { ATT_STEP(T, kA, vA, mA); ATT_STEP(T + 1, kB, vB, mB); }
#undef ATT_STEP
#undef ATT_MATHS
    const float lsum = lsumv + __shfl_xor(lsumv, 32);
    const float inv = 1.f / __builtin_fmaxf(lsum, 1e-30f);
    bf16* op = BR + grow * 1024 + 512 + 64 * h + 4 * hi;
#pragma unroll
    for (int g = 0; g < 4; ++g) { u32x2 a; a.x = pk2(o0[4 * g] * inv, o0[4 * g + 1] * inv); a.y = pk2(o0[4 * g + 2] * inv, o0[4 * g + 3] * inv); *(u32x2*)(op + 8 * g) = a;
        u32x2 c; c.x = pk2(o1[4 * g] * inv, o1[4 * g + 1] * inv); c.y = pk2(o1[4 * g + 2] * inv, o1[4 * g + 3] * inv); *(u32x2*)(op + 32 + 8 * g) = c; }
}

struct Args { const float* in[24]; float* out; unsigned char* ws; int ph_lo, ph_hi, layer_lo, layer_hi; };
#define CAS __attribute__((address_space(4)))
struct ArgsDev { const GAS float* in[24]; GAS float* out; GAS unsigned char* ws; int ph_lo, ph_hi, layer_lo, layer_hi; };
constexpr int NPH = 14;
__global__ void __launch_bounds__(512, 2) mega_fwd(Args args) {
    extern __shared__ __attribute__((aligned(16))) unsigned char lds_raw[];
    Frame F;
    F.lds = (LAS unsigned char*)lds_raw;
    F.tid = threadIdx.x; F.lane = F.tid & 63; F.wave = __builtin_amdgcn_readfirstlane(F.tid >> 6);
    F.G = gridDim.x; F.bx = blockIdx.x; F.ws = args.ws; F.out = args.out;
#pragma unroll
    for (int i = 0; i < 24; ++i) F.in[i] = args.in[i];
    volatile LAS unsigned* MISC = (volatile LAS unsigned*)(F.lds + MISC_OFF);
    if (F.tid < 16) MISC[F.tid] = 0u;
    __syncthreads();
    unsigned* ctl = (unsigned*)(F.ws + WS_CTL);
    XcdBarrier bar = xcd_barrier_post(ctl + CW_BAR, MISC + 8);
    constexpr int lo = 0, hi = NPH; constexpr bool single = false;
#ifndef PHMASK
#define PHMASK 0x3fff
#endif
#ifndef DUPMASK
#define DUPMASK 0
#endif
#define REP(k) for (int rep_ = 0; rep_ < (((DUPMASK) >> (k)) & 1) + 1; ++rep_)
#define IN(k) (((PHMASK >> (k)) & 1) && lo <= (k) && (k) < hi)
#define SEAM(k) do { if (!single || (IN(k) && IN((k) + 1))) xcd_barrier(bar); } while (0)
#define PHASE_ENTER() unsigned char* ws; { size_t z_ = 0; int t_ = threadIdx.x; int b_ = blockIdx.x; asm volatile("" : "+s"(z_), "+v"(t_), "+s"(b_)); \
    const CAS ArgsDev* ap = (const CAS ArgsDev*)((const CAS char*)__builtin_amdgcn_kernarg_segment_ptr() + z_); \
    _Pragma("unroll") for (int i_ = 0; i_ < 24; ++i_) F.in[i_] = (const float*)ap->in[i_]; F.out = (float*)ap->out; ws = (unsigned char*)ap->ws; F.ws = ws; F.tid = t_; F.lane = t_ & 63; F.wave = __builtin_amdgcn_readfirstlane(t_ >> 6); F.bx = b_; } \
    unsigned char* ar = ws + WS_AR; const float* rstd = (const float*)(ws + WS_RSTD); const char* xb = (const char*)(ws + WS_XB); (void)ar; (void)rstd; (void)xb;
    for (int l = 0; l < DEPTH; ++l) {
        if (IN(0) && l == 0) { PHASE_ENTER(); REP(0) convert_layer(F, l); if (l == 0) norm_pass(F, nullptr, nullptr, 0.f, true, false); SEAM(0); }
        if (IN(1)) { PHASE_ENTER(); SchedStd S; S.o.init(128, 22, 256, F.bx); S.A = xb; S.B = (const char*)(ws + WS_WGU1); S.ta = (size_t)256 * 1024 * 2; S.tb = (size_t)256 * 1024 * 2;
            EpiFfn1 E{(bf16*)(ar + AR_HID)}; REP(1) pg8::gemm_phase<EpiFfn1, SchedStd, true, true>(F.lds, 2048, 2048, 2048, S, E); SEAM(1); }
        if (IN(2)) { PHASE_ENTER(); SchedStd S; S.o.init(128, 4, 256, F.bx); S.A = (const char*)(ar + AR_HID); S.B = (const char*)(ws + WS_WD1); S.ta = (size_t)256 * FF * 2; S.tb = (size_t)256 * FF * 2;
            EpiPlain E{(bf16*)(ar + AR_HB), 1024}; REP(2) pg8::gemm_phase<EpiPlain, SchedStd, true, true>(F.lds, FF * 2, FF * 2, FF * 2, S, E); SEAM(2); }
        if (IN(3)) { PHASE_ENTER(); norm_pass(F, (const bf16*)(ar + AR_HB), F.in[2] + l * DM, 0.5f, false, false, true); SEAM(3); }
        if (IN(4)) { PHASE_ENTER(); SchedZ S; S.o.init(128, 9, 256, F.bx); S.X = xb; S.W = (const char*)(ws + WS_WZ);
            EpiZ E{ar};
            REP(4) pg8::gemm_phase<EpiZ, SchedZ, true, true>(F.lds, 2048, 2048, 2048, S, E); SEAM(4); }
        if (IN(5)) { PHASE_ENTER();
#ifndef NO_MIX
            REP(14) { const int c = F.bx; if (c < 256) mixers_unit(F, l, c); }
#endif
#ifndef NO_SEL
            REP(15) for (int i = 0; i < 4; ++i) { const int wgi = F.bx; if (wgi >= 256) break; const int u = (i == 0) ? wgi : (i == 1) ? 511 - wgi : (i == 2) ? 512 + wgi : 1023 - wgi; select_unit(F, u & 3, u >> 2); }
#endif
            SEAM(5); }
        if (IN(6)) { PHASE_ENTER(); REP(6) for (int i = 0; i < 2; ++i) { const int wgi = F.bx; if (wgi >= 256) break; const int bh = 2 * (wgi & 7) + (wgi >> 7), s = (wgi >> 3) & 15;     attn_unit(F, bh >> 2, bh & 3, i == 0 ? 31 - s : s); __syncthreads(); } SEAM(6); }
        if (IN(7)) { PHASE_ENTER();
            { SchedPOwn S; S.wg = F.bx; S.G = F.G; S.A = (const char*)(ws + WS_BR); S.B = (const char*)(ws + WS_WB);
              EpiPlain E{(bf16*)(ar + AR_P), 4096}; pg8::gemm_phase<EpiPlain, SchedPOwn, true, true>(F.lds, 512, 2048, 512, S, E); }
            asm volatile("s_waitcnt vmcnt(0)" ::: "memory"); __syncthreads();
            { SchedGOwn S; S.wg = F.bx; S.A = (const char*)F.out; S.B = (const char*)(ws + WS_WG);
              EpiGate E{(const bf16*)(ar + AR_P), (bf16*)(ws + WS_Y)}; pg8::gemm_phase<EpiGate, SchedGOwn, true, true, true>(F.lds, 1024, 1024, 1024, S, E); }
            SEAM(8); }
        if (IN(9)) { PHASE_ENTER(); SchedStd S; S.o.init(128, 4, 256, F.bx); S.A = (const char*)(ws + WS_Y); S.B = (const char*)(ws + WS_WO); S.ta = (size_t)256 * 1024 * 2; S.tb = (size_t)256 * 1024 * 2;
            EpiPlain E{(bf16*)(ws + WS_BR), 1024}; pg8::gemm_phase<EpiPlain, SchedStd, true, true>(F.lds, 2048, 2048, 2048, S, E); SEAM(9); }
        if (IN(10)) { PHASE_ENTER(); norm_pass(F, (const bf16*)(ws + WS_BR), F.in[6] + l * DM, 1.0f, false, false); SEAM(10); }
        if (IN(11)) { PHASE_ENTER(); SchedStd S; S.o.init(128, 22, 256, F.bx); S.A = xb; S.B = (const char*)(ws + WS_WGU2); S.ta = (size_t)256 * 1024 * 2; S.tb = (size_t)256 * 1024 * 2;
            EpiFfn1 E{(bf16*)(ar + AR_HID)}; pg8::gemm_phase<EpiFfn1, SchedStd, true, true>(F.lds, 2048, 2048, 2048, S, E); SEAM(11); }
        if (IN(12)) { PHASE_ENTER(); SchedStd S; S.o.init(128, 4, 256, F.bx); S.A = (const char*)(ar + AR_HID); S.B = (const char*)(ws + WS_WD2); S.ta = (size_t)256 * FF * 2; S.tb = (size_t)256 * FF * 2;
            EpiPlain E{(bf16*)(ar + AR_HB), 1024}; pg8::gemm_phase<EpiPlain, SchedStd, true, true>(F.lds, FF * 2, FF * 2, FF * 2, S, E); SEAM(12); }
        if (IN(13)) { PHASE_ENTER(); norm_pass(F, (const bf16*)(ar + AR_HB), F.in[20] + l * DM, 0.5f, false, l == DEPTH - 1); if (!single && l + 1 < DEPTH) { convert_layer(F, l + 1); xcd_barrier(bar); } }
    }
#undef IN
#undef SEAM
}

extern "C" void kernel_launch(void* const* d_in, const int* in_sizes, int n_in, void* d_out, int out_size, void* d_ws, size_t ws_size, hipStream_t stream) {
    static int grid = 0;
    if (grid == 0) {
        if (n_in != 24 || out_size != M * DM || ws_size < WS_END) { fprintf(stderr, "kernel_launch: unexpected shapes (n_in %d out %d ws %zu)\n", n_in, out_size, ws_size); grid = -1; return; }
        int dev = 0, cus = 0, per_cu = 0;
        if (hipGetDevice(&dev) != hipSuccess || hipDeviceGetAttribute(&cus, hipDeviceAttributeMultiprocessorCount, dev) != hipSuccess) { grid = -1; return; }
        if (hipFuncSetAttribute((const void*)mega_fwd, hipFuncAttributeMaxDynamicSharedMemorySize, LDS_BYTES) != hipSuccess) { fprintf(stderr, "kernel_launch: hipFuncSetAttribute failed\n"); grid = -1; return; }
        if (hipOccupancyMaxActiveBlocksPerMultiprocessor(&per_cu, (const void*)mega_fwd, 512, LDS_BYTES) != hipSuccess || per_cu < 1) fprintf(stderr, "kernel_launch: occupancy query says %d\n", per_cu);
        (void)hipGetLastError();
        grid = cus < 256 ? cus : 256;
    }
    if (grid < 0) return;
    (void)hipMemsetAsync((char*)d_ws + WS_CTL, 0, CTL_ZERO_BYTES, stream);
    Args a{};
    for (int i = 0; i < 24; ++i) a.in[i] = (const float*)d_in[i];
    a.out = (float*)d_out; a.ws = (unsigned char*)d_ws;
    a.ph_lo = 0; a.ph_hi = NPH; a.layer_lo = 0; a.layer_hi = DEPTH;
    hipLaunchKernelGGL(mega_fwd, dim3(grid), dim3(512), LDS_BYTES, stream, a);
    const hipError_t le = hipPeekAtLastError();
    if (le != hipSuccess) fprintf(stderr, "kernel_launch: launch failed: %s\n", hipGetErrorName(le));
}
```
